# Optimizing an MI355X kernel written in HIP

```python
import math
import jax, jax.numpy as jnp
from jax import lax
import numpy as np

D_MODEL = 1024
BATCH = 4
SEQ = 8192
DEPTH = 2

CHUNK = 64
Q_BLOCK = 128
D_BRANCH = D_MODEL // 2
D_MIX = 3 * D_BRANCH
ATTN_HEADS = D_BRANCH // 128
ATTN_V_DIM = D_BRANCH // ATTN_HEADS
ATTN_QK_DIM = ATTN_V_DIM // 2
GDN_HEADS = D_BRANCH // 128
GDN_HEAD_DIM = D_BRANCH // GDN_HEADS
GDN_CONV = 4
LRU_BLOCKS = D_BRANCH // 128
LRU_BLOCK_DIM = D_BRANCH // LRU_BLOCKS
LRU_CONV = 4
LRU_C = 8.0

NEG_INF = -1e30
SPLIT_SIZES = (D_BRANCH,) * 8 + (GDN_HEADS, GDN_HEADS) + (D_BRANCH, D_BRANCH)
IN_COLS = sum(SPLIT_SIZES)
SPLIT_POINTS = tuple(int(v) for v in np.cumsum(SPLIT_SIZES)[:-1])

kernel_name = "hybrid_diffattn_gdn_rglru_trunk"


def rmsnorm(x, w, eps=1e-6):
    xf = x.astype(jnp.float32)
    y = xf * lax.rsqrt(jnp.mean(xf * xf, axis=-1, keepdims=True) + eps)
    return (y * w.astype(jnp.float32)).astype(x.dtype)


def l2norm(x, eps=1e-6):
    return x * lax.rsqrt(jnp.sum(x * x, axis=-1, keepdims=True) + eps)


def causal_dwconv(x, w):
    K = w.shape[0]
    S = x.shape[1]
    xp = jnp.pad(x, ((0, 0), (K - 1, 0), (0, 0)))
    y = xp[:, 0:S] * w[0]
    for j in range(1, K):
        y = y + xp[:, j:j + S] * w[j]
    return y


def diff_attention(q, k, v, lam, lambda_init, subln_w):
    B, S, _ = q.shape
    H, dq, dv = ATTN_HEADS, ATTN_QK_DIM, ATTN_V_DIM
    q = q.reshape(B, S, H, 2, dq) * (dq ** -0.5)
    k = k.reshape(B, S, H, 2, dq)
    v = v.reshape(B, S, H, dv)
    nb = S // Q_BLOCK
    q_blocks = q.reshape(B, nb, Q_BLOCK, H, 2, dq).transpose(1, 0, 2, 3, 4, 5)
    key_chunk = jnp.arange(S) // CHUNK

    def one_block(args):
        qb, bi = args
        s = jnp.einsum('bqhmd,bkhmd->bhmqk', qb, k).astype(jnp.float32)
        q_chunk = (bi * Q_BLOCK + jnp.arange(Q_BLOCK)) // CHUNK
        mask = key_chunk[None, :] <= q_chunk[:, None]
        p = jax.nn.softmax(jnp.where(mask, s, NEG_INF), axis=-1)
        attn = p[:, :, 0] - lam * p[:, :, 1]
        return jnp.einsum('bhqk,bkhd->bqhd', attn.astype(v.dtype), v)

    o = lax.map(one_block, (q_blocks, jnp.arange(nb)))
    o = o.transpose(1, 0, 2, 3, 4).reshape(B, S, H, dv)
    o = rmsnorm(o, subln_w, 1e-5) * (1.0 - lambda_init)
    return o.reshape(B, S, H * dv)


def chunk_gated_delta_rule(q, k, v, beta, g):
    B, S, H, Dk = q.shape
    Dv = v.shape[-1]
    N = S // CHUNK

    def to_chunks(t):
        return t.reshape(B, N, CHUNK, H, -1).transpose(0, 3, 1, 2, 4)

    q, k, v = to_chunks(q), to_chunks(k), to_chunks(v)
    beta = beta.reshape(B, N, CHUNK, H).transpose(0, 3, 1, 2)
    g = jnp.cumsum(g.reshape(B, N, CHUNK, H).transpose(0, 3, 1, 2), axis=-1)
    tri = jnp.tril(jnp.ones((CHUNK, CHUNK), dtype=bool))
    strict = jnp.tril(jnp.ones((CHUNK, CHUNK), dtype=bool), -1)
    decay = jnp.exp(jnp.where(tri, g[..., :, None] - g[..., None, :], -jnp.inf))
    k_beta = k * beta[..., None]
    v_beta = v * beta[..., None]
    Lmat = jnp.where(strict, jnp.einsum('bhnid,bhnjd->bhnij', k_beta, k) * decay, 0.0)
    eye = jnp.broadcast_to(jnp.eye(CHUNK, dtype=q.dtype), Lmat.shape)
    T = lax.linalg.triangular_solve(eye + Lmat, eye, left_side=True, lower=True,
                                    unit_diagonal=True)
    u = jnp.einsum('bhnij,bhnjd->bhnid', T, v_beta)
    w = jnp.einsum('bhnij,bhnjd->bhnid', T, k_beta * jnp.exp(g)[..., None])
    a_intra = jnp.where(tri, jnp.einsum('bhnid,bhnjd->bhnij', q, k) * decay, 0.0)

    def step(state, xs):
        q_i, k_i, u_i, w_i, g_i, a_i = xs
        v_new = u_i - jnp.einsum('bhcd,bhde->bhce', w_i, state)
        o = (jnp.einsum('bhcd,bhde->bhce', q_i * jnp.exp(g_i)[..., None], state)
             + jnp.einsum('bhij,bhje->bhie', a_i, v_new))
        g_last = g_i[..., -1]
        state = (state * jnp.exp(g_last)[..., None, None]
                 + jnp.einsum('bhcd,bhce->bhde', k_i * jnp.exp(g_last[..., None] - g_i)[..., None], v_new))
        return state, o

    mv = lambda t: jnp.moveaxis(t, 2, 0)
    state0 = jnp.zeros((B, H, Dk, Dv), dtype=q.dtype)
    _, o = lax.scan(step, state0, (mv(q), mv(k), mv(u), mv(w), mv(g), mv(a_intra)))
    return o.transpose(1, 0, 3, 2, 4).reshape(B, S, H, Dv)


def gated_deltanet(q, k, v, b, a, z, conv_w, a_log, dt_bias, norm_w):
    B, S, _ = q.shape
    H, D = GDN_HEADS, GDN_HEAD_DIM
    qkv = jax.nn.silu(causal_dwconv(jnp.concatenate([q, k, v], axis=-1), conv_w)).astype(jnp.float32)
    q, k, v = jnp.split(qkv, 3, axis=-1)
    q = l2norm(q.reshape(B, S, H, D)) * (D ** -0.5)
    k = l2norm(k.reshape(B, S, H, D))
    v = v.reshape(B, S, H, D)
    beta = jax.nn.sigmoid(b.astype(jnp.float32))
    g = -jnp.exp(a_log.astype(jnp.float32)) * jax.nn.softplus(a.astype(jnp.float32) + dt_bias.astype(jnp.float32))
    o = chunk_gated_delta_rule(q, k, v, beta, g)
    o = rmsnorm(o, norm_w) * jax.nn.silu(z.reshape(B, S, H, D).astype(jnp.float32))
    return o.reshape(B, S, H * D)


def rg_lru(xb, conv_w, conv_b, gate_w, gate_b, lam_param):
    B, S, C = xb.shape
    xc = (causal_dwconv(xb, conv_w) + conv_b).astype(jnp.float32)
    xg = xc.reshape(B, S, LRU_BLOCKS, LRU_BLOCK_DIM)
    gates = (jnp.einsum('bsnd,gnde->gbsne', xg, gate_w.astype(jnp.float32))
             + gate_b.astype(jnp.float32).reshape(2, 1, 1, LRU_BLOCKS, LRU_BLOCK_DIM)).reshape(2, B, S, C)
    i_t = jax.nn.sigmoid(gates[0])
    r_t = jax.nn.sigmoid(gates[1])
    log_a = -LRU_C * r_t * jax.nn.softplus(-lam_param.astype(jnp.float32))
    a_t = jnp.exp(log_a)
    b_t = jnp.sqrt(jnp.maximum(-jnp.expm1(2.0 * log_a), 0.0)) * (i_t * xc)

    def combine(e1, e2):
        a1, b1 = e1
        a2, b2 = e2
        return a1 * a2, a2 * b1 + b2

    _, h = lax.associative_scan(combine, (a_t, b_t), axis=1)
    return h


def setup_inputs(seed: int = 0) -> dict:
    key = jax.random.key(seed)
    ks = jax.random.split(key, 20)
    f32 = jnp.float32
    nrm = lambda k, shape, s: jax.random.normal(k, shape, f32) * s
    x = jax.random.normal(ks[0], (BATCH, SEQ, D_MODEL), f32)
    norm_w = 1.0 + nrm(ks[1], (DEPTH, D_MODEL), 0.01)
    w_in = nrm(ks[2], (DEPTH, D_MODEL, IN_COLS), D_MODEL ** -0.5)
    attn_lambda = nrm(ks[3], (DEPTH, 4, ATTN_QK_DIM), 0.1)
    attn_subln_w = 1.0 + nrm(ks[4], (DEPTH, ATTN_V_DIM), 0.01)
    gdn_conv_w = nrm(ks[5], (DEPTH, GDN_CONV, 3 * D_BRANCH), GDN_CONV ** -0.5)
    gdn_a_log = jnp.log(jax.random.uniform(ks[6], (DEPTH, GDN_HEADS), f32, 1.0, 16.0))
    dt = jnp.exp(jax.random.uniform(ks[7], (DEPTH, GDN_HEADS), f32, math.log(1e-3), math.log(1e-1)))
    gdn_dt_bias = dt + jnp.log(-jnp.expm1(-dt))
    gdn_norm_w = 1.0 + nrm(ks[8], (DEPTH, GDN_HEAD_DIM), 0.01)
    lru_conv_w = nrm(ks[9], (DEPTH, LRU_CONV, D_BRANCH), LRU_CONV ** -0.5)
    lru_conv_b = nrm(ks[10], (DEPTH, D_BRANCH), 0.01)
    lru_gate_w = nrm(ks[11], (DEPTH, 2, LRU_BLOCKS, LRU_BLOCK_DIM, LRU_BLOCK_DIM), LRU_BLOCK_DIM ** -0.5)
    lru_gate_b = nrm(ks[12], (DEPTH, 2, D_BRANCH), 0.01)
    u = jax.random.uniform(ks[13], (DEPTH, D_BRANCH), f32, 0.9, 0.999)
    s = u ** (1.0 / LRU_C)
    lru_log_param = jnp.log(s) - jnp.log1p(-s)
    w_out = nrm(ks[14], (DEPTH, D_MIX, D_MODEL), D_MIX ** -0.5)
    final_norm_w = 1.0 + nrm(ks[15], (D_MODEL,), 0.01)
    return {"x": x, "norm_w": norm_w, "w_in": w_in, "attn_lambda": attn_lambda,
            "attn_subln_w": attn_subln_w, "gdn_conv_w": gdn_conv_w, "gdn_a_log": gdn_a_log,
            "gdn_dt_bias": gdn_dt_bias, "gdn_norm_w": gdn_norm_w, "lru_conv_w": lru_conv_w,
            "lru_conv_b": lru_conv_b, "lru_gate_w": lru_gate_w, "lru_gate_b": lru_gate_b,
            "lru_log_param": lru_log_param, "w_out": w_out, "final_norm_w": final_norm_w}


def reference(x, norm_w, w_in, attn_lambda, attn_subln_w, gdn_conv_w, gdn_a_log, gdn_dt_bias,
              gdn_norm_w, lru_conv_w, lru_conv_b, lru_gate_w, lru_gate_b, lru_log_param,
              w_out, final_norm_w):
    dtype = x.dtype
    for l in range(DEPTH):
        h = rmsnorm(x, norm_w[l])
        u = jnp.einsum('bsd,de->bse', h, w_in[l])
        (a_q, a_k, a_v, a_z, g_q, g_k, g_v, g_z, g_b, g_a, r_x, r_z) = jnp.split(u, SPLIT_POINTS, axis=-1)
        lambda_init = 0.8 - 0.6 * math.exp(-0.3 * l)
        lp = attn_lambda[l].astype(jnp.float32)
        lam = jnp.exp(jnp.sum(lp[0] * lp[1])) - jnp.exp(jnp.sum(lp[2] * lp[3])) + lambda_init
        y_a = diff_attention(a_q, a_k, a_v, lam, lambda_init, attn_subln_w[l]) * jax.nn.silu(a_z)
        y_g = gated_deltanet(g_q, g_k, g_v, g_b, g_a, g_z, gdn_conv_w[l], gdn_a_log[l],
                             gdn_dt_bias[l], gdn_norm_w[l])
        y_r = rg_lru(r_x, lru_conv_w[l], lru_conv_b[l], lru_gate_w[l], lru_gate_b[l],
                     lru_log_param[l]) * jax.nn.silu(r_z.astype(jnp.float32))
        y = jnp.concatenate([y_a.astype(dtype), y_g.astype(dtype), y_r.astype(dtype)], axis=-1)
        x = x + jnp.einsum('bse,ed->bsd', y, w_out[l])
    return rmsnorm(x, final_norm_w)
```

```cpp
#include <hip/hip_runtime.h>
#include <hip/hip_bf16.h>
#include <hip/hip_cooperative_groups.h>
#include <cstdio>
#include <cstdint>
#include <cstddef>
__device__ __forceinline__ int otid() { int t = threadIdx.x; asm volatile("" : "+v"(t)); return t; }
__device__ __forceinline__ int obid() { int t = blockIdx.x; asm volatile("" : "+s"(t)); return t; }
__device__ __forceinline__ int ogrid() { int t = gridDim.x; asm volatile("" : "+s"(t)); return t; }
namespace pg8 {
#define PG8_LAS __attribute__((address_space(3)))
typedef unsigned short bf16_t;
typedef short bf16x8 __attribute__((ext_vector_type(8)));
typedef float f32x4 __attribute__((ext_vector_type(4)));
typedef unsigned u32x4 __attribute__((ext_vector_type(4)));
constexpr int BM = 256, BK = 64, HALF = 128, HTB = HALF * BK * 2  , STAGE_BYTES = 8 * HTB, NXCD = 8, WGM = 8;

__host__ __device__ __forceinline__ int lds_byte(int r, int c) { const int st = (r >> 4) * 2 + (c >> 5), rr = r & 15, cc = c & 31, ob = rr * 64 + cc * 2; return st * 1024 + (ob ^ (((ob >> 9) & 1) << 5)); }
__host__ __device__ __forceinline__ void stage_rc(int b, int& R, int& C) { const int st = b / 1024, sb = b % 1024, swz = sb ^ (((sb >> 9) & 1) << 5); R = (st >> 1) * 16 + swz / 64; C = (st & 1) * 32 + (swz % 64) / 2; }
__host__ __device__ __forceinline__ int perm32(int rho) { const int n = rho >> 4, i = rho & 15; return 8 * (i >> 2) + 4 * n + (i & 3); }

struct Unit { int pm, pn; };
struct Gemm { const bf16_t* A; const bf16_t* Bt; int M, N, K, lda; };

struct StaticOrder {
    int nM, nN, nwg, G, c;
    __host__ __device__ void init(int M, int N, int G_, int c_) { nM = M / BM; nN = N / BM; nwg = nM * nN; G = G_; c = c_; }
    __host__ __device__ bool next(int i, Unit& u) const {
        const long L = (long)i * G + c; if (L >= nwg) return false;
        int wgid = (int)L; { const int q = nwg / NXCD, r = nwg % NXCD, xcd = wgid % NXCD, off = wgid / NXCD; wgid = (xcd < r ? xcd * (q + 1) : r * (q + 1) + (xcd - r) * q) + off; }
        const int nig = WGM * nN, gid = wgid / nig, fm = gid * WGM, gsz = (nM - fm) < WGM ? (nM - fm) : WGM;
        u.pm = fm + ((wgid % nig) % gsz); u.pn = (wgid % nig) / gsz; return true;
    }
    __device__ __forceinline__ void a_ready(const Unit&) const {}
    __device__ __forceinline__ void done(const Unit&) const {}
};

__device__ __forceinline__ unsigned cvt_pk_bf16(float lo, float hi) { unsigned r; asm volatile("v_cvt_pk_bf16_f32 %0, %1, %2" : "=v"(r) : "v"(lo), "v"(hi)); return r; }
typedef float f32x2 __attribute__((ext_vector_type(2)));
__device__ __forceinline__ f32x2 gelu_pk(f32x2 v) {
    const f32x2 av = __builtin_elementwise_abs(v), d = av * 0.2316418882f + 1.0f;
    f32x2 t; t.x = __builtin_amdgcn_rcpf(d.x); t.y = __builtin_amdgcn_rcpf(d.y);
    f32x2 q = t * 0.5307027145f + (-0.7265760135f); q = q * t + 0.7107068705f; q = q * t + (-0.142248368f); q = q * t + 0.127414796f; q = q * t;
    const f32x2 s = (v * v) * (-0.72134752044f);
    f32x2 e; e.x = __builtin_amdgcn_exp2f(s.x); e.y = __builtin_amdgcn_exp2f(s.y);
    const f32x2 m = v * (q * e), r = v - m;
    f32x2 o; o.x = v.x < 0.f ? m.x : r.x; o.y = v.y < 0.f ? m.y : r.y; return o;
}

template <int ACT  > struct EpiBf16 {
    static constexpr bool PERM = true, AFTER_DRAIN = false; static_assert(ACT == 0 || ACT == 1, "EpiBf16: ACT is 0 (none) or 1 (gelu_pk)");
    bf16_t* O; int ldc; const float* bias; int split_cols; size_t split_stride; float scale0;
    __device__ __forceinline__ void operator()(const f32x4 (&acc)[2][2][4][2], const Unit& u, int wr, int wc, int fr, int fq) const {
        const int row0 = u.pm * BM + wr * 64 + fr; int colt = u.pn * BM; bf16_t* base = O;
        float sc = 1.f; if (split_cols) { const int t = colt / split_cols; base += (size_t)t * split_stride; colt -= t * split_cols; if (t == 0) sc = scale0; }
        const int col0 = colt + wc * 32 + 8 * fq, bcol0 = u.pn * BM + wc * 32 + 8 * fq;
        f32x4 bv[2][2];
#pragma unroll
        for (int bj = 0; bj < 2; ++bj)
#pragma unroll
            for (int n = 0; n < 2; ++n) bv[bj][n] = bias ? *(const f32x4*)(bias + bcol0 + bj * HALF + 4 * n) : (f32x4){0.f, 0.f, 0.f, 0.f};
#pragma unroll
        for (int ai = 0; ai < 2; ++ai)
#pragma unroll
            for (int m = 0; m < 4; ++m) { bf16_t* rowp = base + (size_t)(row0 + ai * HALF + m * 16) * ldc + col0;
#pragma unroll
                for (int bj = 0; bj < 2; ++bj) { f32x4 v0 = acc[ai][bj][m][0] + bv[bj][0], v1 = acc[ai][bj][m][1] + bv[bj][1];
                    if (ACT == 1) { f32x2 a = gelu_pk((f32x2){v0[0], v0[1]}), b = gelu_pk((f32x2){v0[2], v0[3]}), c = gelu_pk((f32x2){v1[0], v1[1]}), d = gelu_pk((f32x2){v1[2], v1[3]});
                        v0 = (f32x4){a.x, a.y, b.x, b.y}; v1 = (f32x4){c.x, c.y, d.x, d.y}; }
                    v0 = v0 * sc; v1 = v1 * sc; u32x4 w; w.x = cvt_pk_bf16(v0[0], v0[1]); w.y = cvt_pk_bf16(v0[2], v0[3]); w.z = cvt_pk_bf16(v1[0], v1[1]); w.w = cvt_pk_bf16(v1[2], v1[3]);
                    *(u32x4*)(rowp + bj * HALF) = w; } }
    }
};
template <class Epi, class Sched, bool ALIGN_EPI = false, bool SP2 = false>
__device__ __forceinline__ void gemm_phase(PG8_LAS unsigned char* lds, const Gemm g, const Sched& S, const Epi& E) {
    const int tid = otid(), wid = __builtin_amdgcn_readfirstlane(tid >> 6), lane = tid & 63, wr = wid >> 2, wc = wid & 3, fr = lane & 15, fq = lane >> 4;
    const int K = g.K, nt = K / BK;
    unsigned voffA[2], voffB[2];
#pragma unroll
    for (int i = 0; i < 2; ++i) { int R, C; stage_rc(tid * 16 + i * 8192, R, C); const int Rb = Epi::PERM ? ((R & ~31) + perm32(R & 31)) : R;
        voffA[i] = (unsigned)(R * g.lda + C) * 2u; voffB[i] = (unsigned)(Rb * K + C) * 2u; }
    const size_t kstep = (size_t)(BK * 2);
    const size_t hstepB = (size_t)HALF * K * 2; const size_t hstepA = (size_t)HALF * g.lda * 2;
    const size_t tstepA = 2 * hstepA; const size_t tstepB = 2 * hstepB;
    const unsigned ldsw = (unsigned)wid * 1024u;
    const int aoff = lds_byte(wr * 64 + fr, fq * 8), boff = lds_byte(wc * 32 + fr, fq * 8);
#define PG8_SA(b, h) (((b) * 2 + (h)) * HTB)
#define PG8_SB(b, h) ((4 + (b) * 2 + (h)) * HTB)
#define PG8_STAGE(bufoff, gbase, voff) do { _Pragma("unroll") for (int _i = 0; _i < 2; ++_i) \
        __builtin_amdgcn_global_load_lds((const unsigned*)((const char*)(gbase) + (voff)[_i]), (PG8_LAS unsigned*)(lds + (bufoff) + ldsw + _i * 8192), 16, 0, 0); } while (0)
#define PG8_LDA(dst, b, h) do { _Pragma("unroll") for (int m = 0; m < 4; ++m) _Pragma("unroll") for (int k = 0; k < 2; ++k) dst[m][k] = *(const PG8_LAS bf16x8*)(lds + PG8_SA(b, h) + aoff + m * 2048 + k * 1024); } while (0)
#define PG8_LDB(dst, b, h) do { _Pragma("unroll") for (int n = 0; n < 2; ++n) _Pragma("unroll") for (int k = 0; k < 2; ++k) dst[n][k] = *(const PG8_LAS bf16x8*)(lds + PG8_SB(b, h) + boff + n * 2048 + k * 1024); } while (0)
#define PG8_MMA(ai, bj, At, Bt) do { __builtin_amdgcn_s_setprio(1); _Pragma("unroll") for (int m = 0; m < 4; ++m) _Pragma("unroll") for (int n = 0; n < 2; ++n) _Pragma("unroll") for (int k = 0; k < 2; ++k) \
        acc[ai][bj][m][n] = __builtin_amdgcn_mfma_f32_16x16x32_bf16(Bt[n][k], At[m][k], acc[ai][bj][m][n], 0, 0, 0); __builtin_amdgcn_s_setprio(0); } while (0)
#define PG8_WAIT_V(n) asm volatile("s_waitcnt vmcnt(" #n ")" ::: "memory")
#define PG8_WAIT_L(n) asm volatile("s_waitcnt lgkmcnt(" #n ")" ::: "memory")
#define PG8_BAR __builtin_amdgcn_s_barrier()
#define PG8_SCHED __builtin_amdgcn_sched_barrier(0)
    Unit cur, nxt; int ui = 0;
    if (!S.next(0, cur)) return;
    f32x4 acc[2][2][4][2];
#pragma unroll
    for (int a = 0; a < 2; ++a)
#pragma unroll
        for (int b = 0; b < 2; ++b)
#pragma unroll
            for (int m = 0; m < 4; ++m)
#pragma unroll
                for (int n = 0; n < 2; ++n) acc[a][b][m][n] = (f32x4){0.f, 0.f, 0.f, 0.f};
    bf16x8 At[4][2], B0[2][2], B1[2][2];
    const char* cA = (const char*)g.A + (size_t)cur.pm * tstepA; const char* cB = (const char*)g.Bt + (size_t)cur.pn * tstepB;
    S.a_ready(cur);
    if constexpr (SP2) {
        PG8_STAGE(PG8_SB(0, 0), cB, voffB); PG8_STAGE(PG8_SB(0, 1), cB + hstepB, voffB); PG8_STAGE(PG8_SA(0, 0), cA, voffA); PG8_STAGE(PG8_SA(0, 1), cA + hstepA, voffA);
        if (wr == 1) PG8_BAR;
        PG8_WAIT_V(2); PG8_BAR;
        PG8_STAGE(PG8_SB(1, 0), cB + kstep, voffB); PG8_STAGE(PG8_SA(1, 0), cA + kstep, voffA); PG8_STAGE(PG8_SB(1, 1), cB + hstepB + kstep, voffB);
        PG8_WAIT_V(6); PG8_BAR;
    } else {
        PG8_STAGE(PG8_SB(0, 0), cB, voffB); PG8_STAGE(PG8_SA(0, 0), cA, voffA); PG8_STAGE(PG8_SB(0, 1), cB + hstepB, voffB); PG8_STAGE(PG8_SA(0, 1), cA + hstepA, voffA);
        if (wr == 1) PG8_BAR;
        PG8_WAIT_V(4); PG8_BAR;
        PG8_STAGE(PG8_SB(1, 0), cB + kstep, voffB); PG8_STAGE(PG8_SA(1, 0), cA + kstep, voffA); PG8_STAGE(PG8_SB(1, 1), cB + hstepB + kstep, voffB);
        PG8_WAIT_V(6); PG8_BAR;
    }
    for (;;) {
        const bool has_next = S.next(ui + 1, nxt);
        const char* nA = has_next ? (const char*)g.A + (size_t)nxt.pm * tstepA : cA; const char* nB = has_next ? (const char*)g.Bt + (size_t)nxt.pn * tstepB : cB;
        for (int t = 0; t < nt; t += 2) {
            const bool last = (t == nt - 2);
            const char* a1 = cA + (size_t)(t + 1) * kstep;
            const char* a2 = last ? nA : cA + (size_t)(t + 2) * kstep; const char* b2 = last ? nB : cB + (size_t)(t + 2) * kstep;
            const char* a3 = a2 + kstep; const char* b3 = b2 + kstep;
            if (last && has_next) S.a_ready(nxt);
            if constexpr (SP2) {
            PG8_LDB(B0, 0, 0); PG8_LDB(B1, 0, 1); PG8_SCHED; PG8_LDA(At, 0, 0); PG8_STAGE(PG8_SA(1, 1), a1 + hstepA, voffA);
            PG8_WAIT_V(8); PG8_WAIT_L(0); PG8_BAR; PG8_MMA(0, 0, At, B0); PG8_MMA(0, 1, At, B1); PG8_BAR; PG8_SCHED;
            PG8_LDA(At, 0, 1); PG8_STAGE(PG8_SB(0, 0), b2, voffB); PG8_STAGE(PG8_SB(0, 1), b2 + hstepB, voffB); PG8_STAGE(PG8_SA(0, 0), a2, voffA);
            PG8_WAIT_V(8); PG8_WAIT_L(0); PG8_BAR; PG8_MMA(1, 0, At, B0); PG8_MMA(1, 1, At, B1); PG8_BAR; PG8_SCHED;
            PG8_LDB(B0, 1, 0); PG8_LDB(B1, 1, 1); PG8_SCHED; PG8_LDA(At, 1, 0); PG8_STAGE(PG8_SA(0, 1), a2 + hstepA, voffA);
            PG8_WAIT_V(8); PG8_WAIT_L(0); PG8_BAR; PG8_MMA(0, 0, At, B0); PG8_MMA(0, 1, At, B1); PG8_BAR; PG8_SCHED;
            PG8_LDA(At, 1, 1); PG8_STAGE(PG8_SB(1, 0), b3, voffB); PG8_STAGE(PG8_SB(1, 1), b3 + hstepB, voffB); PG8_STAGE(PG8_SA(1, 0), a3, voffA);
            PG8_WAIT_V(8); PG8_WAIT_L(0); PG8_BAR; PG8_MMA(1, 0, At, B0); PG8_MMA(1, 1, At, B1); PG8_BAR; PG8_SCHED;
            } else {
            PG8_LDB(B0, 0, 0); PG8_SCHED; PG8_LDA(At, 0, 0); PG8_STAGE(PG8_SA(1, 1), a1 + hstepA, voffA);
            PG8_WAIT_L(8); PG8_BAR; PG8_WAIT_L(0); PG8_MMA(0, 0, At, B0); PG8_BAR; PG8_SCHED;
            PG8_LDB(B1, 0, 1); PG8_STAGE(PG8_SB(0, 0), b2, voffB);
            PG8_BAR; PG8_WAIT_L(0); PG8_MMA(0, 1, At, B1); PG8_BAR;
            PG8_LDA(At, 0, 1); PG8_STAGE(PG8_SA(0, 0), a2, voffA);
            PG8_BAR; PG8_WAIT_L(0); PG8_MMA(1, 0, At, B0); PG8_BAR; PG8_SCHED;
            PG8_STAGE(PG8_SB(0, 1), b2 + hstepB, voffB);
            PG8_WAIT_V(6); PG8_BAR; PG8_MMA(1, 1, At, B1); PG8_BAR;
            PG8_LDB(B0, 1, 0); PG8_SCHED; PG8_LDA(At, 1, 0); PG8_STAGE(PG8_SA(0, 1), a2 + hstepA, voffA);
            PG8_WAIT_L(8); PG8_BAR; PG8_WAIT_L(0); PG8_MMA(0, 0, At, B0); PG8_BAR; PG8_SCHED;
            PG8_LDB(B1, 1, 1); PG8_STAGE(PG8_SB(1, 0), b3, voffB);
            PG8_BAR; PG8_WAIT_L(0); PG8_MMA(0, 1, At, B1); PG8_BAR;
            PG8_LDA(At, 1, 1); PG8_STAGE(PG8_SA(1, 0), a3, voffA);
            PG8_BAR; PG8_WAIT_L(0); PG8_MMA(1, 0, At, B0); PG8_BAR; PG8_SCHED;
            PG8_STAGE(PG8_SB(1, 1), b3 + hstepB, voffB);
            PG8_WAIT_V(6); PG8_BAR; PG8_MMA(1, 1, At, B1); PG8_BAR;
            }
        }
        if constexpr (ALIGN_EPI) { if (wr == 0) PG8_BAR; }
        if constexpr (!Epi::AFTER_DRAIN) { E(acc, cur, wr, wc, fr, fq); S.done(cur); }
        if (!has_next) break;
#pragma unroll
        for (int a = 0; a < 2; ++a)
#pragma unroll
            for (int b = 0; b < 2; ++b)
#pragma unroll
                for (int m = 0; m < 4; ++m)
#pragma unroll
                    for (int n = 0; n < 2; ++n) acc[a][b][m][n] = (f32x4){0.f, 0.f, 0.f, 0.f};
        cur = nxt; cA = nA; cB = nB; ++ui;
        if constexpr (ALIGN_EPI) { if (wr == 1) PG8_BAR; }
    }
    PG8_WAIT_V(0);
    if constexpr (!ALIGN_EPI) { if (wr == 0) PG8_BAR; }
    PG8_BAR;
    if constexpr (Epi::AFTER_DRAIN) { E.fused(acc, cur, wr, wc, fr, fq, lds, wid, lane); S.done(cur); }
#undef PG8_SA
#undef PG8_SB
#undef PG8_STAGE
#undef PG8_LDA
#undef PG8_LDB
#undef PG8_MMA
#undef PG8_WAIT_V
#undef PG8_WAIT_L
#undef PG8_BAR
#undef PG8_SCHED
}
}
namespace attn2 {
constexpr int D = 128, DQ = 64, PU = 5120, PO = 1024;
constexpr float SCALE = 0.6931471805599453f;
constexpr float THR = 8.f;
constexpr bool WSKIP = false;
constexpr int NW = 8, QBLK = 32, KVBLK = 64, QB = NW * QBLK;
constexpr int SHM_V = KVBLK * D * 2, SHM_K = KVBLK * DQ * 2;
constexpr int LDS_BYTES = 2 * SHM_V + 2 * SHM_K + NW * 64 * 4;

using bf16 = __hip_bfloat16;
typedef short bf16x8 __attribute__((ext_vector_type(8)));
typedef short s16x4 __attribute__((ext_vector_type(4)));
typedef float f32x16 __attribute__((ext_vector_type(16)));
typedef float f32x4 __attribute__((ext_vector_type(4)));
typedef unsigned u32x4 __attribute__((ext_vector_type(4)));
template <class A, class Bt> struct same_t { static constexpr bool v = false; };
template <class A> struct same_t<A, A> { static constexpr bool v = true; };

#define KSWZ(row, colB) ((row) * 128 + ((colB) ^ (((row) & 7) << 4)))
#define SBAR() __builtin_amdgcn_sched_barrier(0)
__device__ __forceinline__ int v_st(int k, int c) { const int kk = (k & ~0xC) | ((k & 4) << 1) | ((k & 8) >> 1); return ((kk >> 3) * 4 + (c >> 5)) * 512 + ((kk & 7) * 32 + (c & 31)) * 2; }
__device__ __forceinline__ int v_rd_base(int lane) { return ((lane & 3) << 3) | (((lane >> 2) & 3) << 6) | (((lane >> 4) & 1) << 5) | (((lane >> 5) & 1) << 8); }
constexpr int v_rd_off(int d0, int ks, int half) { return d0 * 512 + ks * 4096 + half * 2048; }
__device__ __forceinline__ int crow(int r, int hi) { return (r & 3) + 8 * (r >> 2) + 4 * hi; }
__device__ __forceinline__ unsigned cvtpk(float lo, float hi) {
    unsigned r; asm volatile("v_cvt_pk_bf16_f32 %0, %1, %2" : "=v"(r) : "v"(lo), "v"(hi)); return r;
}
__device__ __forceinline__ bf16x8 pack8(f32x4 a, f32x4 b) {
    u32x4 w = {cvtpk(a[0], a[1]), cvtpk(a[2], a[3]), cvtpk(b[0], b[1]), cvtpk(b[2], b[3])};
    return *reinterpret_cast<bf16x8*>(&w);
}
template <class T> __device__ __forceinline__ bf16x8 load8(const T* p) {
    if constexpr (same_t<T, float>::v) { return pack8(*(const f32x4*)p, *(const f32x4*)(p + 4)); }
    else { return *reinterpret_cast<const bf16x8*>(p); }
}
__device__ __forceinline__ void mask_tile(f32x16& p0, f32x16& p1, int dq, unsigned W) {
    const float NEG = -__builtin_inff();
#pragma unroll
    for (int r = 0; r < 16; ++r) {
        const int c = (r & 3) + 8 * (r >> 2);
        if ((unsigned)(dq - c) >= W) p0[r] = NEG;
        if ((unsigned)(dq - c - 32) >= W) p1[r] = NEG;
    }
}
__device__ __forceinline__ void partialSM(f32x16& p0, f32x16& p1, float& m_reg, float& mn, float& alpha) {
    float pmax = p0[0]; for (int r = 1; r < 16; ++r) pmax = fmaxf(pmax, p0[r]); for (int r = 0; r < 16; ++r) pmax = fmaxf(pmax, p1[r]);
    { auto rr = __builtin_amdgcn_permlane32_swap(__float_as_uint(pmax), __float_as_uint(pmax), false, false);
      pmax = fmaxf(__uint_as_float(rr[0]), __uint_as_float(rr[1])); }
    constexpr float C2 = 1.4426950408889634f * SCALE;
    if (__builtin_expect(__all((pmax - m_reg) * SCALE <= THR), 1)) { mn = m_reg; alpha = 1.f; }
    else { mn = fmaxf(m_reg, pmax); alpha = __builtin_amdgcn_exp2f((m_reg - mn) * C2); m_reg = mn; }
    const float mnL = -mn * C2;
    { typedef float f32x2p __attribute__((ext_vector_type(2))); const f32x2p c2v = {C2, C2}, mv = {mnL, mnL};
#pragma unroll
      for (int r = 0; r < 16; r += 2) { f32x2p a = {p0[r], p0[r + 1]}, b = {p1[r], p1[r + 1]}; a = a * c2v + mv; b = b * c2v + mv; p0[r] = a.x; p0[r + 1] = a.y; p1[r] = b.x; p1[r + 1] = b.y; } }
    for (int r = 0; r < 16; ++r) p0[r] = __builtin_amdgcn_exp2f(p0[r]);
}
__device__ __forceinline__ void finishSM(f32x16& p0, f32x16& p1, float alpha, float& l_reg, bf16x8& pa0, bf16x8& pa1, bf16x8& pa2, bf16x8& pa3) {
    for (int r = 0; r < 16; ++r) p1[r] = __builtin_amdgcn_exp2f(p1[r]);
    float ps; { typedef float f32x2p __attribute__((ext_vector_type(2))); f32x2p s2 = {p0[0], p0[1]};
#pragma unroll
      for (int r = 2; r < 16; r += 2) s2 += (f32x2p){p0[r], p0[r + 1]};
#pragma unroll
      for (int r = 0; r < 16; r += 2) s2 += (f32x2p){p1[r], p1[r + 1]};
      ps = s2.x + s2.y; }
    { auto rr = __builtin_amdgcn_permlane32_swap(__float_as_uint(ps), __float_as_uint(ps), false, false);
      ps = __uint_as_float(rr[0]) + __uint_as_float(rr[1]); }
    l_reg = l_reg * alpha + ps;
#define PK4(P, B_, OUT) do { unsigned a0 = cvtpk(P[B_+0], P[B_+1]), a1 = cvtpk(P[B_+2], P[B_+3]);                          \
        unsigned b0 = cvtpk(P[B_+4], P[B_+5]), b1 = cvtpk(P[B_+6], P[B_+7]);                                             \
        auto r0 = __builtin_amdgcn_permlane32_swap(a0, b0, false, false); auto r1 = __builtin_amdgcn_permlane32_swap(a1, b1, false, false); \
        u32x4 w = {r0[0], r1[0], r0[1], r1[1]}; OUT = *reinterpret_cast<bf16x8*>(&w); } while (0)
    PK4(p0, 0, pa0); PK4(p0, 8, pa1); PK4(p1, 0, pa2); PK4(p1, 8, pa3);
#undef PK4
}
template <int KB, bool SK>
__device__ __forceinline__ void qkt(f32x16& p0, f32x16& p1, const char* K_lds, int r32, int hi, const bf16x8* qr, bool act) {
    if (SK && !act) { const float NEG = -__builtin_inff();
#pragma unroll
        for (int r = 0; r < 16; ++r) { p0[r] = NEG; p1[r] = NEG; } return; }
    p0 = f32x16{}; p1 = f32x16{};
    const char* kb[4];
#pragma unroll
    for (int dd = 0; dd < 4; ++dd) kb[dd] = K_lds + KB * SHM_K + KSWZ(r32, (dd * 16 + hi * 8) * 2);
#pragma unroll
    for (int d0 = 0; d0 < 4; ++d0) { const char* a = kb[d0];
        bf16x8 b0 = *reinterpret_cast<const bf16x8*>(a);
        bf16x8 b1 = *reinterpret_cast<const bf16x8*>(a + 32 * 128);
        p0 = __builtin_amdgcn_mfma_f32_32x32x16_bf16(b0, qr[d0], p0, 0, 0, 0);
        p1 = __builtin_amdgcn_mfma_f32_32x32x16_bf16(b1, qr[d0], p1, 0, 0, 0); }
}
template <int VB, bool SK>
__device__ __forceinline__ void pv_tile(f32x16* o, int vb0, bf16x8 pa0, bf16x8 pa1, bf16x8 pa2, bf16x8 pa3, bool act) {
    if (SK && !act) return;
#define TRRD(dst, off) asm volatile("ds_read_b64_tr_b16 %0, %1 offset:%2" : "=&v"(dst) : "v"(vb0), "i"(off) : "memory")
#define PV_D0(d0) do { s16x4 l0, l1, l2, l3, h0, h1, h2, h3; constexpr int b_ = VB * SHM_V + v_rd_off(d0, 0, 0);     \
        TRRD(l0, b_); TRRD(h0, b_ + 2048); TRRD(l1, b_ + 4096); TRRD(h1, b_ + 6144); TRRD(l2, b_ + 8192); TRRD(h2, b_ + 10240); TRRD(l3, b_ + 12288); TRRD(h3, b_ + 14336); \
        asm volatile("s_waitcnt lgkmcnt(0)" ::: "memory"); SBAR();                 \
        o[d0] = __builtin_amdgcn_mfma_f32_32x32x16_bf16(pa0, (bf16x8){l0[0], l0[1], l0[2], l0[3], h0[0], h0[1], h0[2], h0[3]}, o[d0], 0, 0, 0);   \
        o[d0] = __builtin_amdgcn_mfma_f32_32x32x16_bf16(pa1, (bf16x8){l1[0], l1[1], l1[2], l1[3], h1[0], h1[1], h1[2], h1[3]}, o[d0], 0, 0, 0);   \
        o[d0] = __builtin_amdgcn_mfma_f32_32x32x16_bf16(pa2, (bf16x8){l2[0], l2[1], l2[2], l2[3], h2[0], h2[1], h2[2], h2[3]}, o[d0], 0, 0, 0);   \
        o[d0] = __builtin_amdgcn_mfma_f32_32x32x16_bf16(pa3, (bf16x8){l3[0], l3[1], l3[2], l3[3], h3[0], h3[1], h3[2], h3[3]}, o[d0], 0, 0, 0); } while (0)
    PV_D0(0); PV_D0(1); PV_D0(2); PV_D0(3);
#undef PV_D0
#undef TRRD
}

template <int VB>
__device__ __forceinline__ void pv_sm(f32x16* o, int vb0, bf16x8 pa0, bf16x8 pa1, bf16x8 pa2, bf16x8 pa3, f32x16& p0, f32x16& p1, float& m_reg, float& mn, float& alpha) {
    typedef float f32x2p __attribute__((ext_vector_type(2)));
    constexpr float C2 = 1.4426950408889634f * SCALE;
    s16x4 l0, h0, l1, h1, l2, h2, l3, h3;
#define TRRD(dst, off) asm volatile("ds_read_b64_tr_b16 %0, %1 offset:%2" : "=&v"(dst) : "v"(vb0), "i"(off) : "memory")
#define LOADKS(ks) do { constexpr int b_ = VB * SHM_V + (ks) * 4096; TRRD(l0, b_); TRRD(h0, b_ + 2048); TRRD(l1, b_ + 512); TRRD(h1, b_ + 512 + 2048); \
        TRRD(l2, b_ + 1024); TRRD(h2, b_ + 1024 + 2048); TRRD(l3, b_ + 1536); TRRD(h3, b_ + 1536 + 2048); asm volatile("s_waitcnt lgkmcnt(0)" ::: "memory"); SBAR(); } while (0)
#define FRAG(l, h) (bf16x8){l[0], l[1], l[2], l[3], h[0], h[1], h[2], h[3]}
#define MMAKS(pa) do { o[0] = __builtin_amdgcn_mfma_f32_32x32x16_bf16(pa, FRAG(l0, h0), o[0], 0, 0, 0); o[1] = __builtin_amdgcn_mfma_f32_32x32x16_bf16(pa, FRAG(l1, h1), o[1], 0, 0, 0); \
        o[2] = __builtin_amdgcn_mfma_f32_32x32x16_bf16(pa, FRAG(l2, h2), o[2], 0, 0, 0); o[3] = __builtin_amdgcn_mfma_f32_32x32x16_bf16(pa, FRAG(l3, h3), o[3], 0, 0, 0); } while (0)
#define GRP4(nv) do { _Pragma("unroll") for (int g_ = 0; g_ < 4; ++g_) { __builtin_amdgcn_sched_group_barrier(0x008, 1, 0); __builtin_amdgcn_sched_group_barrier(0x002, nv, 0); } } while (0)
    LOADKS(0); MMAKS(pa0);
    float pmax = p0[0];
#pragma unroll
    for (int r = 1; r < 16; ++r) pmax = fmaxf(pmax, p0[r]);
#pragma unroll
    for (int r = 0; r < 16; ++r) pmax = fmaxf(pmax, p1[r]);
    GRP4(5); SBAR();
    LOADKS(1); MMAKS(pa1);
    { auto rr = __builtin_amdgcn_permlane32_swap(__float_as_uint(pmax), __float_as_uint(pmax), false, false);
      pmax = fmaxf(__uint_as_float(rr[0]), __uint_as_float(rr[1])); }
    const bool ok = __all((pmax - m_reg) * SCALE <= THR);
    const float mnew = fmaxf(m_reg, pmax);
    mn = ok ? m_reg : mnew; alpha = ok ? 1.f : __builtin_amdgcn_exp2f((m_reg - mnew) * C2); m_reg = mn;
    const f32x2p c2v = {C2, C2}, mv = {-mn * C2, -mn * C2};
#pragma unroll
    for (int r = 0; r < 16; r += 2) { f32x2p a = {p0[r], p0[r + 1]}; a = a * c2v + mv; p0[r] = a.x; p0[r + 1] = a.y; }
    GRP4(5); SBAR();
    LOADKS(2);
#define MM1(d, pa, l, h) o[d] = __builtin_amdgcn_mfma_f32_32x32x16_bf16(pa, FRAG(l, h), o[d], 0, 0, 0)
#define SH1(r) do { f32x2p b = {p1[r], p1[r + 1]}; b = b * c2v + mv; p1[r] = b.x; p1[r + 1] = b.y; } while (0)
#define EX1(r) p0[r] = __builtin_amdgcn_exp2f(p0[r])
    MM1(0, pa2, l0, h0); SH1(0); SH1(2); SH1(4); SH1(6);
    MM1(1, pa2, l1, h1); SH1(8); SH1(10); SH1(12); SH1(14);
    MM1(2, pa2, l2, h2); EX1(0); EX1(1); EX1(2); EX1(3);
    MM1(3, pa2, l3, h3); EX1(4); EX1(5); EX1(6); EX1(7);
    asm volatile("" : "+v"(p0), "+v"(p1));
    { __builtin_amdgcn_sched_group_barrier(0x008, 1, 0); __builtin_amdgcn_sched_group_barrier(0x402, 4, 0); __builtin_amdgcn_sched_group_barrier(0x008, 1, 0); __builtin_amdgcn_sched_group_barrier(0x402, 4, 0);
      __builtin_amdgcn_sched_group_barrier(0x008, 1, 0); __builtin_amdgcn_sched_group_barrier(0x402, 4, 0); __builtin_amdgcn_sched_group_barrier(0x008, 1, 0); __builtin_amdgcn_sched_group_barrier(0x402, 4, 0); }
    SBAR();
    LOADKS(3);
    MM1(0, pa3, l0, h0); EX1(8); EX1(9);
    MM1(1, pa3, l1, h1); EX1(10); EX1(11);
    MM1(2, pa3, l2, h2); EX1(12); EX1(13);
    MM1(3, pa3, l3, h3); EX1(14); EX1(15);
    asm volatile("" : "+v"(p0));
    { __builtin_amdgcn_sched_group_barrier(0x008, 1, 0); __builtin_amdgcn_sched_group_barrier(0x402, 2, 0); __builtin_amdgcn_sched_group_barrier(0x008, 1, 0); __builtin_amdgcn_sched_group_barrier(0x402, 2, 0);
      __builtin_amdgcn_sched_group_barrier(0x008, 1, 0); __builtin_amdgcn_sched_group_barrier(0x402, 2, 0); __builtin_amdgcn_sched_group_barrier(0x008, 1, 0); __builtin_amdgcn_sched_group_barrier(0x402, 2, 0); }
    SBAR();
#undef MM1
#undef SH1
#undef EX1
#undef TRRD
#undef LOADKS
#undef FRAG
#undef MMAKS
#undef GRP4
}
template <class TIn, class TOut> struct BlockRef { const TIn* Q; const TIn* K; const TIn* V; TOut* O; int P0; };
template <class TIn> struct Seam {
    bf16x8 qr[4];
    bf16x8 st_v0, st_v1, st_k0;
};
__device__ __forceinline__ int swa_jlo(int P0, int W) { const int lowk = P0 - W + 1; return lowk > 0 ? lowk / KVBLK : 0; }
#define ROW(p, k0, rr) ((p) + (size_t)((k0) + (rr)) * PU + sc)
#define ROWK(p, k0) ((p) + (size_t)((k0) + skr) * PU + skc)
#define VMW() asm volatile("s_waitcnt vmcnt(0)" ::: "memory")
#define VMWN(n) asm volatile("s_waitcnt vmcnt(%0)" :: "i"(n) : "memory")
#define SLOAD_H(Kp, Vp, k0) do { S.st_v0 = load8<TIn>(ROW(Vp, k0, sr)); S.st_v1 = load8<TIn>(ROW(Vp, k0, 32 + sr));              \
                         S.st_k0 = load8<TIn>(ROWK(Kp, k0)); } while (0)
#define SWRITE_HK(bf) do { *(bf16x8*)(K_lds + (bf) * SHM_K + kws) = S.st_k0; } while (0)
#define SWRITE_HV(bf) do { *(bf16x8*)(V_lds + (bf) * SHM_V + vst0) = S.st_v0; *(bf16x8*)(V_lds + (bf) * SHM_V + vst1) = S.st_v1; } while (0)
#define SWRITE_H(bf) do { SWRITE_HV(bf); SWRITE_HK(bf); } while (0)
#define SLOAD_F(p, k0) do { S.sf0 = *(const f32x4*)ROW(p, k0, sr); S.sf1 = *(const f32x4*)(ROW(p, k0, sr) + 4);                \
                            S.sf2 = *(const f32x4*)ROW(p, k0, 32 + sr); S.sf3 = *(const f32x4*)(ROW(p, k0, 32 + sr) + 4); } while (0)
#define SWRITE_KF(bf) do { *(bf16x8*)(K_lds + (bf) * SHM_K + kws) = pack8(S.sf0, S.sf1); *(bf16x8*)(K_lds + (bf) * SHM_K + kws + 32 * 256) = pack8(S.sf2, S.sf3); } while (0)
#define SWRITE_VF(bf) do { *(bf16x8*)(V_lds + (bf) * SHM_V + vst0) = pack8(S.sf0, S.sf1); *(bf16x8*)(V_lds + (bf) * SHM_V + vst1) = pack8(S.sf2, S.sf3); } while (0)
template <class TIn, class TOut>
__device__ __forceinline__ void causal_swa_prime(const BlockRef<TIn, TOut>& cur, int W, char* lds, Seam<TIn>& S) {
    constexpr bool F32 = same_t<TIn, float>::v;
    const int tid = otid(), wid = __builtin_amdgcn_readfirstlane(tid >> 6), lane = tid & 63, r32 = lane & 31, hi = lane >> 5;
    const int sr = tid >> 4, sc = (tid & 15) * 8, skr = tid >> 3, skc = (tid & 7) * 8, kws = KSWZ(skr, skc * 2); char* K_lds = lds + 2 * SHM_V;
    const int kb0 = swa_jlo(cur.P0, W) * KVBLK;
    for (int d0 = 0; d0 < 4; ++d0) S.qr[d0] = load8<TIn>(cur.Q + (size_t)(wid * QBLK + r32) * PU + d0 * 16 + hi * 8);
    if constexpr (F32) { SLOAD_F((const float*)cur.K, kb0); VMW(); SWRITE_KF(0); SBAR(); SLOAD_F((const float*)cur.V, kb0); }
    else { SLOAD_H(cur.K, cur.V, kb0); VMW(); SWRITE_HK(0); }
    __syncthreads();
}
template <class TIn, class TOut>
__device__ __forceinline__ void causal_swa_block(const BlockRef<TIn, TOut>& cur, const BlockRef<TIn, TOut>& nxt, int skv, int W, char* lds, Seam<TIn>& S) {
    constexpr bool F32 = same_t<TIn, float>::v;
    const int tid = otid(), wid = __builtin_amdgcn_readfirstlane(tid >> 6), lane = tid & 63, r32 = lane & 31, hi = lane >> 5;
    const int j_lo = swa_jlo(cur.P0, W);
    int j_hi = (cur.P0 + QB - 1) / KVBLK + 1; if (j_hi > skv / KVBLK) j_hi = skv / KVBLK;
    const int NT = j_hi - j_lo;
    const int kbn = swa_jlo(nxt.P0, W) * KVBLK;
    const int qeff = (cur.P0 + wid * QBLK) | 63;
    char* V_lds = lds; char* K_lds = lds + 2 * SHM_V;
    float* ws = (float*)(lds + 2 * SHM_V + 2 * SHM_K) + wid * 64; float* li_l = ws, * al_l = ws + 32;
    float m_reg = -1e30f, l_reg = 0; f32x16 o[4] = {};
    const int sr = tid >> 4, sc = (tid & 15) * 8, vst0 = v_st(sr, sc), vst1 = v_st(32 + sr, sc), skr = tid >> 3, skc = (tid & 7) * 8, kws = KSWZ(skr, skc * 2);
    const int vb0 = (int)(uintptr_t)V_lds + v_rd_base(lane);
    const TIn* Kh = cur.K; const TIn* Vh = cur.V;
#define RESC(a) do { if (__any((a) < 1.f)) { if (hi == 0) al_l[r32] = (a); asm volatile("s_waitcnt lgkmcnt(0)" ::: "memory");              \
                     for (int d_ = 0; d_ < 4; ++d_) for (int r = 0; r < 16; ++r) o[d_][r] *= al_l[crow(r, hi)]; } } while (0)
#define KBASE(t) ((j_lo + (t)) * KVBLK)
#define ACT(t) (KBASE(t) <= qeff)
#define MASKT(P0_, P1_, t) do { if (__builtin_expect(!ACT(t), 0)) { asm volatile("" ::: "memory");     \
        const float NEG_ = -__builtin_inff(); _Pragma("unroll") for (int r_ = 0; r_ < 16; ++r_) { P0_[r_] = NEG_; P1_[r_] = NEG_; } } } while (0)
    constexpr int NQL = F32 ? 16 : 4;
    constexpr bool SK = WSKIP && !F32;
#define SEAM_K0() do { VMWN(NQL); if constexpr (F32) { SWRITE_KF(0); SBAR(); SLOAD_F((const float*)nxt.V, kbn); } else { SWRITE_HK(0); } SBAR(); } while (0)
    f32x16 pA0, pA1, pB0, pB1; float mnA, mnB, alA, alB; bf16x8 pa0, pa1, pa2, pa3;
    if constexpr (F32) { VMW(); SWRITE_VF(0); SBAR(); } else { SWRITE_HV(0); SBAR(); }
    if (NT > 1) { if constexpr (F32) SLOAD_F((const float*)Kh, KBASE(1)); else SLOAD_H(Kh, Vh, KBASE(1)); }
    SBAR(); qkt<0, SK>(pA0, pA1, K_lds, r32, hi, S.qr, ACT(0));
    if constexpr (F32) { if (NT > 1) { VMW(); SWRITE_KF(1); SBAR(); SLOAD_F((const float*)Vh, KBASE(1)); } }
    MASKT(pA0, pA1, 0); partialSM(pA0, pA1, m_reg, mnA, alA);
    if (NT > 1) { VMW(); if constexpr (F32) { SWRITE_VF(1); SBAR(); if (NT > 2) SLOAD_F((const float*)Kh, KBASE(2)); } else SWRITE_H(1); }
    __syncthreads();
#define HALF_STEP(PX0, PX1, mnX, alX, PY0, PY1, alY, t, KB, VB, SB) do {                                                      \
        SBAR(); qkt<KB, SK>(PX0, PX1, K_lds, r32, hi, S.qr, ACT(t));                                             \
        finishSM(PY0, PY1, alY, l_reg, pa0, pa1, pa2, pa3); SBAR();                                                           \
        if ((t) + 1 < NT) { if constexpr (F32) { VMW(); SWRITE_KF(SB); SBAR(); SLOAD_F((const float*)Vh, KBASE((t) + 1)); }  \
                            else { SLOAD_H(Kh, Vh, KBASE((t) + 1)); } SBAR(); }                                               \
        MASKT(PX0, PX1, (t)); pv_sm<VB>(o, vb0, pa0, pa1, pa2, pa3, PX0, PX1, m_reg, mnX, alX);                                                                          \
        __syncthreads();                                                                                                      \
        if ((t) + 1 < NT) { VMW(); if constexpr (F32) { SWRITE_VF(SB); SBAR(); if ((t) + 2 < NT) SLOAD_F((const float*)Kh, KBASE((t) + 2)); } \
                            else { SWRITE_H(SB); } }                                                                          \
        RESC(alX); __syncthreads(); } while (0)
    for (int t = 1; t + 1 < NT; t += 2) {
        HALF_STEP(pB0, pB1, mnB, alB, pA0, pA1, alA, t, 1, 0, 0);
        HALF_STEP(pA0, pA1, mnA, alA, pB0, pB1, alB, t + 1, 0, 1, 1);
    }
    const bool even = (NT & 1) == 0;
    if (even) { SBAR(); qkt<1, SK>(pB0, pB1, K_lds, r32, hi, S.qr, ACT(NT - 1)); SBAR(); }
#define QROW(e) (nxt.Q + (size_t)(wid * QBLK + r32) * D + ((e) >> 1) * 16 + hi * 8 + ((e) & 1) * 4)
    if constexpr (F32) { SLOAD_F((const float*)nxt.K, kbn); SBAR();
#pragma unroll
        for (int e = 0; e < 8; ++e) S.tq[e] = *(const f32x4*)QROW(e); }
    else { SLOAD_H(nxt.K, nxt.V, kbn); SBAR();
#pragma unroll
        for (int d0 = 0; d0 < 4; ++d0) S.qr[d0] = load8<TIn>(nxt.Q + (size_t)(wid * QBLK + r32) * PU + d0 * 16 + hi * 8); }
    SBAR();
    finishSM(pA0, pA1, alA, l_reg, pa0, pa1, pa2, pa3); SBAR();
    if constexpr (F32) {
#pragma unroll
        for (int e = 8; e < 16; ++e) S.tq[e] = *(const f32x4*)QROW(e); SBAR(); }
#undef QROW
    pv_tile<0, SK>(o, vb0, pa0, pa1, pa2, pa3, ACT(even ? NT - 2 : NT - 1));
    if (even) { MASKT(pB0, pB1, NT - 1); partialSM(pB0, pB1, m_reg, mnB, alB); __syncthreads(); RESC(alB);
        finishSM(pB0, pB1, alB, l_reg, pa0, pa1, pa2, pa3); SBAR(); pv_tile<1, SK>(o, vb0, pa0, pa1, pa2, pa3, ACT(NT - 1)); }
    SBAR(); SEAM_K0();
    if (hi == 0) li_l[r32] = l_reg; asm volatile("s_waitcnt lgkmcnt(0)" ::: "memory");
    float rli[16];
#pragma unroll
    for (int r = 0; r < 16; ++r) rli[r] = __builtin_amdgcn_rcpf(li_l[crow(r, hi)]);
    TOut* Ow = cur.O + (size_t)(wid * QBLK) * PO;
#pragma unroll
    for (int r = 0; r < 16; ++r) { const int orow = crow(r, hi);
#pragma unroll
        for (int d0 = 0; d0 < 4; ++d0) { const float v = o[d0][r] * rli[r];
            if constexpr (same_t<TOut, float>::v) { Ow[(size_t)orow * PO + d0 * 32 + r32] = v; }
            else { const float vn = __shfl_xor(v, 1);
                   if ((r32 & 1) == 0) *(unsigned*)(Ow + (size_t)orow * PO + d0 * 32 + r32) = cvtpk(v, vn); } } }
    if constexpr (F32) {
#pragma unroll
        for (int d0 = 0; d0 < 8; ++d0) S.qr[d0] = pack8(S.tq[2 * d0], S.tq[2 * d0 + 1]); }
    __syncthreads();
#undef RESC
#undef KBASE
#undef ACT
#undef MASKT
#undef SEAM_K0
#undef HALF_STEP
}
#undef ROW
#undef VMW
#undef VMWN
#undef SLOAD_H
#undef SWRITE_HK
#undef SWRITE_HV
#undef SWRITE_H
#undef SLOAD_F
#undef SWRITE_KF
#undef SWRITE_VF

}
namespace cg = cooperative_groups;
#define LAS __attribute__((address_space(3)))
typedef unsigned short bf16;
typedef unsigned v4u __attribute__((ext_vector_type(4)));
typedef unsigned v2u __attribute__((ext_vector_type(2)));
typedef float f32x4 __attribute__((ext_vector_type(4)));

constexpr int NWAVES = 8, NTHR = 512;
constexpr int BATCH = 4, SEQ = 8192, DMODEL = 1024, M = BATCH * SEQ;
constexpr int NU = 5120, NY = 1536, INC = 5128;
constexpr int U_AQ = 0, U_AK = 512, U_AV = 1024, U_AZ = 1536, U_GQ = 2048, U_GK = 2560, U_GV = 3072, U_GZ = 3584, U_RX = 4096, U_RZ = 4608;
constexpr size_t MiB = 1u << 20;
constexpr size_t WS_CTL = 0, WS_WIN = 2 * MiB, WS_WOUT = 22 * MiB, WS_WG = 28 * MiB, WS_GBA = 30 * MiB, WS_XN = 32 * MiB, WS_U = 96 * MiB, WS_Y = 416 * MiB, WS_END = 512 * MiB;
constexpr int RING_BYTES = 131072, MISC_OFF = RING_BYTES + 320, LDS_BYTES = 147456;
constexpr float ATT_C2 = 0.125f * 1.4426950408889634f;
constexpr int N_GDN_UNITS = 16, N_LRU_UNITS = 128, N_ATT_UNITS = 1024;

__device__ __forceinline__ unsigned f2bf(float f) { unsigned u = __builtin_bit_cast(unsigned, f); return (u + 0x7fffu + ((u >> 16) & 1u)) >> 16; }
__device__ __forceinline__ unsigned pk2(float lo, float hi) { return f2bf(lo) | (f2bf(hi) << 16); }
__device__ __forceinline__ float bflo(unsigned w) { return __builtin_bit_cast(float, w << 16); }
__device__ __forceinline__ float bfhi(unsigned w) { return __builtin_bit_cast(float, w & 0xffff0000u); }
__device__ __forceinline__ float bf1(bf16 v) { return __builtin_bit_cast(float, (unsigned)v << 16); }
__device__ __forceinline__ float fexp(float x) { return __builtin_amdgcn_exp2f(x * 1.4426950408889634f); }
__device__ __forceinline__ float flog(float x) { return __builtin_amdgcn_logf(x) * 0.6931471805599453f; }
__device__ __forceinline__ float sigmoidf_(float x) { return __builtin_amdgcn_rcpf(1.0f + fexp(-x)); }
__device__ __forceinline__ float softplusf_(float x) {
    if (x > 20.f) return x;
    const float y = fexp(x);
    return y < 0.01f ? y * (1.f - y * (0.5f - y * 0.33333334f)) : flog(1.f + y);
}
__device__ __forceinline__ float wave_sum(float v) {
#pragma unroll
    for (int o = 1; o < 64; o <<= 1) v += __shfl_xor(v, o);
    return v;
}
template <int CTRL> __device__ __forceinline__ float dpp_f(float x) {
    return __builtin_bit_cast(float, __builtin_amdgcn_update_dpp(0, __builtin_bit_cast(int, x), CTRL, 0xF, 0xF, false));
}
__device__ __forceinline__ float row16_sum(float x) {
    x += dpp_f<0x128>(x); x += dpp_f<0x124>(x); x += dpp_f<0x122>(x); x += dpp_f<0x121>(x); return x;
}

struct Args { const float* in[16]; float* out; unsigned char* ws; };

typedef const __attribute__((address_space(4))) Args* KArgP;
__device__ __forceinline__ KArgP kargs() { KArgP p = (KArgP)__builtin_amdgcn_kernarg_segment_ptr(); asm volatile("" : "+s"(p)); return p; }
struct TI { int tid, lane, wave, G; };
__device__ __forceinline__ TI ti() { TI t; t.tid = otid(); t.lane = t.tid & 63; t.wave = __builtin_amdgcn_readfirstlane(t.tid >> 6); t.G = ogrid(); return t; }

namespace pg8 {
struct EpiRes {
    static constexpr bool PERM = false, AFTER_DRAIN = false;
    const float* base; float* out; int ldc;
    __device__ __forceinline__ void operator()(const f32x4 (&acc)[2][2][4][2], const Unit& u, int wr, int wc, int fr, int fq) const {
        const int col0 = u.pn * BM + wc * 32 + 4 * fq;
#pragma unroll
        for (int ai = 0; ai < 2; ++ai)
#pragma unroll
            for (int m = 0; m < 4; ++m) { const size_t off = (size_t)(u.pm * BM + ai * HALF + wr * 64 + m * 16 + fr) * ldc + col0;
#pragma unroll
                for (int bj = 0; bj < 2; ++bj)
#pragma unroll
                    for (int n = 0; n < 2; ++n) { const f32x4 bs = *(const f32x4*)(base + off + bj * HALF + n * 16); *(f32x4*)(out + off + bj * HALF + n * 16) = bs + acc[ai][bj][m][n]; } }
    }
};
struct EpiGate {
    static constexpr bool PERM = true, AFTER_DRAIN = false;
    bf16_t* O0; int ldc0; bf16_t* O1; int ldc1; const float* bias;
    __device__ __forceinline__ void operator()(const f32x4 (&acc)[2][2][4][2], const Unit& u, int wr, int wc, int fr, int fq) const {
        const int row0 = u.pm * BM + wr * 64 + fr; int colt = u.pn * BM; const int t = colt / 512; bf16_t* base = t ? O1 : O0; const int ldc = t ? ldc1 : ldc0; colt -= t * 512;
        const int col0 = colt + wc * 32 + 8 * fq, bcol0 = u.pn * BM + wc * 32 + 8 * fq;
        f32x4 bv[2][2];
#pragma unroll
        for (int bj = 0; bj < 2; ++bj)
#pragma unroll
            for (int n = 0; n < 2; ++n) bv[bj][n] = *(const f32x4*)(bias + bcol0 + bj * HALF + 4 * n);
#pragma unroll
        for (int ai = 0; ai < 2; ++ai)
#pragma unroll
            for (int m = 0; m < 4; ++m) { bf16_t* rowp = base + (size_t)(row0 + ai * HALF + m * 16) * ldc + col0;
#pragma unroll
                for (int bj = 0; bj < 2; ++bj) { const f32x4 v0 = acc[ai][bj][m][0] + bv[bj][0], v1 = acc[ai][bj][m][1] + bv[bj][1];
                    u32x4 w; w.x = cvt_pk_bf16(v0[0], v0[1]); w.y = cvt_pk_bf16(v0[2], v0[3]); w.z = cvt_pk_bf16(v1[0], v1[1]); w.w = cvt_pk_bf16(v1[2], v1[3]);
                    *(u32x4*)(rowp + bj * HALF) = w; } }
    }
};
}

__device__ __forceinline__ void transpose_item(const float* W, int pitch, int K, bf16* WT, LAS float* scr, int kb, int nb, int lane) {
    const int k0 = 64 * kb, n0 = 32 * nb;
#pragma unroll 8
    for (int i = 0; i < 32; ++i) { const int kk = 2 * i + (lane >> 5); scr[kk * 33 + (lane & 31)] = W[(size_t)(k0 + kk) * pitch + n0 + (lane & 31)]; }
    asm volatile("s_waitcnt lgkmcnt(0)" ::: "memory");
    const int c = lane & 7;
#pragma unroll
    for (int j = 0; j < 4; ++j) { const int n = (lane >> 3) + 8 * j; const LAS float* s = scr + (8 * c) * 33 + n;
        v4u o; o.x = pk2(s[0 * 33], s[1 * 33]); o.y = pk2(s[2 * 33], s[3 * 33]); o.z = pk2(s[4 * 33], s[5 * 33]); o.w = pk2(s[6 * 33], s[7 * 33]);
        *(v4u*)(WT + (size_t)(n0 + n) * K + k0 + 8 * c) = o; }
    asm volatile("s_waitcnt lgkmcnt(0)" ::: "memory");
}
__device__ __forceinline__ void p0_weights(LAS unsigned char* lds, const float* w_in, const float* w_out, const float* lru_gate_w, bf16* Wt_in, bf16* Wt_out, bf16* Wt_g) {
    const TI F = ti();
    LAS float* scr = (LAS float*)(lds + F.wave * 16384);
    const int gw = obid() * NWAVES + F.wave, NGW = F.G * NWAVES;
    constexpr int I_A = 16 * 128, I_B = 16 * 32, I_O = 24 * 32, PER_L = I_A + I_B + I_O;
    for (int it = gw; it < 2 * PER_L; it += NGW) {
        const int l = it / PER_L; int r = it % PER_L;
        const float* win = w_in + (size_t)l * DMODEL * INC; bf16* wt = Wt_in + (size_t)l * NU * DMODEL;
        if (r < I_A) { transpose_item(win, INC, DMODEL, wt, scr, r / 128, r % 128, F.lane); continue; } r -= I_A;
        if (r < I_B) { transpose_item(win + 4104, INC, DMODEL, wt + (size_t)4096 * DMODEL, scr, r / 32, r % 32, F.lane); continue; } r -= I_B;
        transpose_item(w_out + (size_t)l * NY * DMODEL, DMODEL, NY, Wt_out + (size_t)l * DMODEL * NY, scr, r / 32, r % 32, F.lane);
    }
    for (int idx = obid() * NTHR + F.tid; idx < 2 * 1024 * 256; idx += F.G * NTHR) {
        const int l = idx >> 18, rem = idx & 262143, n = rem >> 8, k = (rem & 255) * 2;
        const int g = n >> 9, nb = (n >> 7) & 3, e = n & 127, kb = k >> 7, d = k & 127;
        unsigned w = 0u;
        if (kb == nb) { const float* gw_ = lru_gate_w + ((((size_t)(l * 2 + g) * 4 + nb) * 128 + d) * 128 + e); w = pk2(gw_[0], gw_[128]); }
        *(unsigned*)(Wt_g + (size_t)l * 1024 * 512 + (size_t)n * 512 + k) = w;
    }
}

__device__ __forceinline__ void norm_phase(LAS unsigned char* lds, const float* xsrc, const float* win, const float* nw, bf16* XN, float* GBA) {
    const TI F = ti();
    LAS float* wg = (LAS float*)lds;
    for (int idx = F.tid; idx < 8192; idx += NTHR) { const int k = idx >> 3, j = idx & 7; wg[j * 1024 + k] = win[(size_t)k * INC + 4096 + j]; }
    __syncthreads();
    f32x4 wv[4];
#pragma unroll
    for (int j = 0; j < 4; ++j) wv[j] = *(const f32x4*)(nw + 4 * F.lane + 256 * j);
    const int gw = obid() * NWAVES + F.wave, NGW = F.G * NWAVES;
    const int lane = F.lane; const bool b32 = (lane & 32) != 0, b16 = (lane & 16) != 0, b8 = (lane & 8) != 0;
    for (int row0 = gw * 2; row0 < M; row0 += NGW * 2) {
        f32x4 v[2][4]; float s[2];
#pragma unroll
        for (int rr = 0; rr < 2; ++rr) { const f32x4* xr = (const f32x4*)(xsrc + (size_t)(row0 + rr) * DMODEL) + lane; s[rr] = 0.f;
#pragma unroll
            for (int j = 0; j < 4; ++j) { v[rr][j] = xr[64 * j]; s[rr] += (v[rr][j].x * v[rr][j].x + v[rr][j].y * v[rr][j].y) + (v[rr][j].z * v[rr][j].z + v[rr][j].w * v[rr][j].w); } }
#pragma unroll
        for (int rr = 0; rr < 2; ++rr) { const int row = row0 + rr;
            const float r = rsqrtf(wave_sum(s[rr]) * (1.0f / DMODEL) + 1e-6f);
            unsigned long long* o8 = (unsigned long long*)(XN + (size_t)row * DMODEL) + lane;
            float acc[8];
#pragma unroll
            for (int jj = 0; jj < 8; ++jj) acc[jj] = 0.f;
#pragma unroll
            for (int j = 0; j < 4; ++j) {
                const f32x4 hv = v[rr][j] * r * wv[j];
                o8[64 * j] = (unsigned long long)pk2(hv.x, hv.y) | ((unsigned long long)pk2(hv.z, hv.w) << 32);
#pragma unroll
                for (int jj = 0; jj < 8; ++jj) { const f32x4 w4 = *(const LAS f32x4*)(wg + jj * 1024 + 4 * lane + 256 * j);
                    acc[jj] += (hv.x * w4.x + hv.y * w4.y) + (hv.z * w4.z + hv.w * w4.w); }
            }
            float t4[4], u2[2];
#pragma unroll
            for (int k = 0; k < 4; ++k) { const float send = b32 ? acc[k] : acc[k + 4], keep = b32 ? acc[k + 4] : acc[k]; t4[k] = keep + __shfl_xor(send, 32); }
#pragma unroll
            for (int k = 0; k < 2; ++k) { const float send = b16 ? t4[k] : t4[k + 2], keep = b16 ? t4[k + 2] : t4[k]; u2[k] = keep + __shfl_xor(send, 16); }
            float w1; { const float send = b8 ? u2[0] : u2[1], keep = b8 ? u2[1] : u2[0]; w1 = keep + __shfl_xor(send, 8); }
            w1 += __shfl_xor(w1, 4); w1 += __shfl_xor(w1, 2); w1 += __shfl_xor(w1, 1);
            if ((lane & 7) == 0) GBA[(size_t)row * 8 + (lane >> 3)] = w1;
        }
    }
    __syncthreads();
}
__device__ __forceinline__ void final_norm_phase(float* out, const float* fnw) {
    const TI F = ti();
    f32x4 wv[4];
#pragma unroll
    for (int j = 0; j < 4; ++j) wv[j] = *(const f32x4*)(fnw + 4 * F.lane + 256 * j);
    const int gw = obid() * NWAVES + F.wave, NGW = F.G * NWAVES;
    for (int row0 = gw * 2; row0 < M; row0 += NGW * 2) {
        f32x4 v[2][4]; float s[2];
#pragma unroll
        for (int rr = 0; rr < 2; ++rr) { const f32x4* xr = (const f32x4*)(out + (size_t)(row0 + rr) * DMODEL) + F.lane; s[rr] = 0.f;
#pragma unroll
            for (int j = 0; j < 4; ++j) { v[rr][j] = xr[64 * j]; s[rr] += (v[rr][j].x * v[rr][j].x + v[rr][j].y * v[rr][j].y) + (v[rr][j].z * v[rr][j].z + v[rr][j].w * v[rr][j].w); } }
#pragma unroll
        for (int rr = 0; rr < 2; ++rr) { const int row = row0 + rr; f32x4* xr = (f32x4*)(out + (size_t)row * DMODEL) + F.lane;
            const float r = rsqrtf(wave_sum(s[rr]) * (1.0f / DMODEL) + 1e-6f);
#pragma unroll
            for (int j = 0; j < 4; ++j) xr[64 * j] = v[rr][j] * r * wv[j]; }
    }
}

__device__ __forceinline__ void unpack8(const v4u w, float (&f)[8]) {
    f[0] = bflo(w.x); f[1] = bfhi(w.x); f[2] = bflo(w.y); f[3] = bfhi(w.y); f[4] = bflo(w.z); f[5] = bfhi(w.z); f[6] = bflo(w.w); f[7] = bfhi(w.w);
}
__device__ __forceinline__ v4u pack8(const float* y) { v4u o; o.x = pk2(y[0], y[1]); o.y = pk2(y[2], y[3]); o.z = pk2(y[4], y[5]); o.w = pk2(y[6], y[7]); return o; }
__device__ __forceinline__ void lru_conv_phase(const float* cwl, const float* cbl, const bf16* U, bf16* Y) {
    const TI F = ti();
    const int cgp = F.tid & 63, ts = F.tid >> 6, c0 = cgp * 8;
    float w[4][8], bb[8];
#pragma unroll
    for (int j = 0; j < 4; ++j) { const f32x4 a = *(const f32x4*)(cwl + (size_t)j * 512 + c0), b = *(const f32x4*)(cwl + (size_t)j * 512 + c0 + 4);
        w[j][0] = a.x; w[j][1] = a.y; w[j][2] = a.z; w[j][3] = a.w; w[j][4] = b.x; w[j][5] = b.y; w[j][6] = b.z; w[j][7] = b.w; }
    { const f32x4 a = *(const f32x4*)(cbl + c0), b = *(const f32x4*)(cbl + c0 + 4);
      bb[0] = a.x; bb[1] = a.y; bb[2] = a.z; bb[3] = a.w; bb[4] = b.x; bb[5] = b.y; bb[6] = b.z; bb[7] = b.w; }
    for (int tile = obid(); tile < M / 64; tile += F.G) {
        const int row0 = tile * 64 + ts * 8, tin = row0 & (SEQ - 1);
        float p1[8], p2[8], p3[8], cur[8];
        const bf16* src = U + (size_t)row0 * NU + U_RX + c0;
        if (tin == 0) {
#pragma unroll
            for (int c = 0; c < 8; ++c) { p1[c] = 0.f; p2[c] = 0.f; p3[c] = 0.f; }
        } else {
            unpack8(*(const v4u*)(src - 1 * (ptrdiff_t)NU), p1); unpack8(*(const v4u*)(src - 2 * (ptrdiff_t)NU), p2); unpack8(*(const v4u*)(src - 3 * (ptrdiff_t)NU), p3);
        }
#pragma unroll
        for (int i = 0; i < 8; ++i) {
            unpack8(*(const v4u*)(src + (size_t)i * NU), cur);
            float y[8];
#pragma unroll
            for (int c = 0; c < 8; ++c) y[c] = bb[c] + w[0][c] * p3[c] + w[1][c] * p2[c] + w[2][c] * p1[c] + w[3][c] * cur[c];
            v4u o; o.x = pk2(y[0], y[1]); o.y = pk2(y[2], y[3]); o.z = pk2(y[4], y[5]); o.w = pk2(y[6], y[7]);
            *(v4u*)(Y + (size_t)(row0 + i) * NY + 1024 + c0) = o;
#pragma unroll
            for (int c = 0; c < 8; ++c) { p3[c] = p2[c]; p2[c] = p1[c]; p1[c] = cur[c]; }
        }
    }
}

__device__ __forceinline__ void lru_unit(LAS unsigned char* lds, int w, const float* lpl, const bf16* U, bf16* Y) {
    const TI F = ti();
    const int b = w >> 5, c0 = (w & 31) * 16, seg = F.tid >> 4, c = F.tid & 15, ch = c0 + c;
    LAS float* segP = (LAS float*)lds; LAS float* segH = segP + 512;
    const float lp = lpl[ch];
    const float sp = softplusf_(-lp);
    const float c8 = -8.0f * sp;
    const size_t rowb = (size_t)b * SEQ + (size_t)seg * 256;
    const bf16* pxc = Y + rowb * NY + 1024 + ch; const bf16* pg0 = U + rowb * NU + U_RX + ch; const bf16* pg1 = Y + rowb * NY + ch; const bf16* pz = U + rowb * NU + U_RZ + ch;
    float h = 0.f, P = 1.f;
#pragma unroll 4
    for (int t = 0; t < 256; ++t) {
        const float xc = bf1(pxc[(size_t)t * NY]), g0 = bf1(pg0[(size_t)t * NU]), g1 = bf1(pg1[(size_t)t * NY]);
        const float it = sigmoidf_(g0), rt = sigmoidf_(g1), la = c8 * rt, a = fexp(la);
        const float bt = sqrtf(fmaxf(1.0f - a * a, 0.f)) * (it * xc);
        h = a * h + bt; P *= a;
    }
    segP[seg * 16 + c] = P; segH[seg * 16 + c] = h;
    __syncthreads();
    float hin = 0.f;
    for (int s = 0; s < seg; ++s) hin = segP[s * 16 + c] * hin + segH[s * 16 + c];
    h = hin;
    bf16* py = Y + rowb * NY + 1024 + ch;
#pragma unroll 4
    for (int t = 0; t < 256; ++t) {
        const float xc = bf1(pxc[(size_t)t * NY]), g0 = bf1(pg0[(size_t)t * NU]), g1 = bf1(pg1[(size_t)t * NY]), z = bf1(pz[(size_t)t * NU]);
        const float it = sigmoidf_(g0), rt = sigmoidf_(g1), la = c8 * rt, a = fexp(la);
        const float bt = sqrtf(fmaxf(1.0f - a * a, 0.f)) * (it * xc);
        h = a * h + bt;
        py[(size_t)t * NY] = (bf16)f2bf(h * z * sigmoidf_(z));
    }
    __syncthreads();
}

__device__ __forceinline__ void gdn_halo_load(LAS unsigned char* L, const bf16* U) {
    const TI F = ti(); const int bid = obid();
    for (int slot = 0; slot < 2; ++slot) { const int tile = bid + slot * F.G; if (tile >= M / 64) break; const size_t t0 = (size_t)tile * 64;
        for (int idx = F.tid; idx < 576; idx += NTHR) { const int row = idx / 192, g = idx % 192; unsigned z = 0u; asm volatile("" : "+v"(z)); v4u v = (v4u){z, z, z, z};
            if ((t0 & (SEQ - 1)) != 0) v = *(const v4u*)(U + (t0 - 3 + row) * NU + U_GQ + g * 8);
            *(LAS v4u*)(L + slot * 9216 + row * 3072 + g * 16) = v; } }
}
__device__ __forceinline__ void gdn_conv_inplace(LAS unsigned char* L, bf16* U, const float* cwl) {
    const TI F = ti(); const int bid = obid();
    if (F.tid >= 384) return;
    const int slot = F.tid / 192, g = F.tid % 192, tile = bid + slot * F.G;
    if (tile >= M / 64) return;
    float cw[4][8];
#pragma unroll
    for (int j = 0; j < 4; ++j) { const float* wp = cwl + (size_t)j * 1536 + g * 8; const f32x4 a = *(const f32x4*)wp, bq = *(const f32x4*)(wp + 4);
        cw[j][0] = a.x; cw[j][1] = a.y; cw[j][2] = a.z; cw[j][3] = a.w; cw[j][4] = bq.x; cw[j][5] = bq.y; cw[j][6] = bq.z; cw[j][7] = bq.w; }
    float p1[8], p2[8], p3[8], cur[8];
    unpack8(*(const LAS v4u*)(L + slot * 9216 + 0 * 3072 + g * 16), p3); unpack8(*(const LAS v4u*)(L + slot * 9216 + 1 * 3072 + g * 16), p2); unpack8(*(const LAS v4u*)(L + slot * 9216 + 2 * 3072 + g * 16), p1);
    bf16* base = U + (size_t)tile * 64 * NU + U_GQ + g * 8;
#pragma unroll 1
    for (int blk = 0; blk < 8; ++blk) { v4u raw[8];
#pragma unroll
        for (int ii = 0; ii < 8; ++ii) raw[ii] = *(const v4u*)(base + (size_t)(blk * 8 + ii) * NU);
#pragma unroll
        for (int ii = 0; ii < 8; ++ii) { unpack8(raw[ii], cur); float y[8];
#pragma unroll
            for (int c = 0; c < 8; ++c) { const float a = cw[0][c] * p3[c] + cw[1][c] * p2[c] + cw[2][c] * p1[c] + cw[3][c] * cur[c]; y[c] = a * sigmoidf_(a); }
            *(v4u*)(base + (size_t)(blk * 8 + ii) * NU) = pack8(y);
#pragma unroll
            for (int c = 0; c < 8; ++c) { p3[c] = p2[c]; p2[c] = p1[c]; p1[c] = cur[c]; } } }
}

typedef short bf16x8_t __attribute__((ext_vector_type(8)));
typedef float f32x16_t __attribute__((ext_vector_type(16)));
#define MFMA32(a, b, c) __builtin_amdgcn_mfma_f32_32x32x16_bf16((a), (b), (c), 0, 0, 0)
constexpr int PQ = 272, PT = 144, LP = 68;
constexpr int GO_QH = 0, GO_KT = 17408, GO_ST = 35840, GO_KH = 70656, GO_VT = 88064, GO_LF = 106496, GO_T1 = 123904, GO_T2 = GO_T1 + 9216, GO_SC = 142336;
__device__ __forceinline__ bf16x8_t ldfrag(LAS unsigned char* base, int row, int pitch, int kbyte) { return *(const LAS bf16x8_t*)(base + row * pitch + kbyte); }
__device__ __forceinline__ void gdn_prep(LAS unsigned char* L, int unit, int next_unit, v4u (&pre)[8], float& pgb0, float& pgb1, const float* alogl, const float* dtbl, const float* GBA, bf16* U, bf16* Y, bf16* AiBuf, float* ScBuf) {
    const TI F = ti(); const int tid0 = F.tid, wave = F.wave;
    const int bh = unit >> 7, n = unit & 127, b = bh >> 2, h = bh & 3;
    LAS float* SCb = (LAS float*)(L + GO_SC);
    LAS float* Lf = (LAS float*)(L + GO_LF);
    LAS float* part = (LAS float*)(L + GO_T1);
    const int gi = tid0 % 48, run = tid0 / 48;
    const int ucol = gi < 16 ? U_GQ + h * 128 + gi * 8 : (gi < 32 ? U_GK + h * 128 + (gi - 16) * 8 : U_GV + h * 128 + (gi - 32) * 8);
    const float A_neg = -fexp(alogl[h]), dtb = dtbl[h];
    const int mi = wave >> 2, ne = wave & 3, md = wave >> 1, nh = wave & 1;
    const size_t t0 = (size_t)b * SEQ + (size_t)n * 64;
#define REOPQ() int tid = tid0; asm volatile("" : "+v"(tid)); const int lane = tid & 63; int r32 = lane & 31, hi = lane >> 5; (void)lane; (void)r32; (void)hi
#define RELAUNDER() asm volatile("" : "+v"(r32), "+v"(hi))
        { REOPQ();
        if (tid < 384) {
            const int ib = run * 8;
            if (gi < 32) {
#pragma unroll
                for (int ii = 0; ii < 8; ++ii) { float x[8]; unpack8(pre[ii], x); float ss = 0.f;
#pragma unroll
                    for (int c = 0; c < 8; ++c) ss += x[c] * x[c];
                    part[(ib + ii) * 32 + gi] = ss; }
            }
            if (gi < 16) {
#pragma unroll
                for (int ii = 0; ii < 8; ++ii) *(LAS v4u*)(L + GO_QH + (ib + ii) * PQ + gi * 16) = pre[ii];
            } else {
                if (gi < 32) {
#pragma unroll
                    for (int ii = 0; ii < 8; ++ii) *(LAS v4u*)(L + GO_KH + (ib + ii) * PQ + (gi - 16) * 16) = pre[ii];
                }
                LAS unsigned char* tb = gi < 32 ? (L + GO_KT + ((gi - 16) * 8) * PT + ib * 2) : (L + GO_VT + ((gi - 32) * 8) * PT + ib * 2);
#pragma unroll
                for (int c = 0; c < 8; ++c) { v4u o;
                    const unsigned sel = (c & 1) ? 0x07060302u : 0x05040100u;
                    o.x = __builtin_amdgcn_perm(pre[1][c >> 1], pre[0][c >> 1], sel); o.y = __builtin_amdgcn_perm(pre[3][c >> 1], pre[2][c >> 1], sel);
                    o.z = __builtin_amdgcn_perm(pre[5][c >> 1], pre[4][c >> 1], sel); o.w = __builtin_amdgcn_perm(pre[7][c >> 1], pre[6][c >> 1], sel);
                    *(LAS v4u*)(tb + c * PT) = o; }
            }
        }
        if (wave == 7) {
            const float beta = sigmoidf_(pgb0); const float ax = pgb1 + dtb; const float spl = softplusf_(ax);
            float g = A_neg * spl;
#pragma unroll
            for (int o = 1; o < 64; o <<= 1) { const float t = __shfl_up(g, o); if (lane >= o) g += t; }
            const float gl = __shfl(g, 63);
            SCb[lane] = beta; SCb[64 + lane] = g; SCb[128 + lane] = fexp(g); SCb[192 + lane] = fexp(gl - g);
        }
        __syncthreads();
        { const int d = tid >> 2, pt = tid & 3;
          const v4u a = *(const LAS v4u*)(L + GO_KT + d * PT + pt * 32), bq = *(const LAS v4u*)(L + GO_KT + d * PT + pt * 32 + 16);
          bf16* dst = U + (t0 + (d >> 1)) * NU + U_GK + h * 128 + (d & 1) * 64 + pt * 16;
          *(v4u*)dst = a; *(v4u*)(dst + 8) = bq; }
        if (tid < 128) { const int i = tid & 63, w = tid >> 6; const LAS float* pp = part + i * 32 + w * 16; float s = 0.f;
#pragma unroll
            for (int q = 0; q < 4; ++q) { const f32x4 p4 = *(const LAS f32x4*)(pp + q * 4); s += (p4.x + p4.y) + (p4.z + p4.w); }
            float r = rsqrtf(s + 1e-6f);
            if (w == 0) { r *= 0.08838834764831845f; SCb[256 + i] = r; SCb[384 + i] = SCb[128 + i] * r; }
            else { SCb[320 + i] = r; SCb[448 + i] = SCb[192 + i] * r; SCb[512 + i] = SCb[i] * SCb[128 + i] * r; } }
        }
        { REOPQ();
        const int mt = (wave >> 1) & 1, nt = wave & 1; const bool isKK = wave < 4;
        f32x16_t acc2;
#pragma unroll
        for (int r = 0; r < 16; ++r) acc2[r] = 0.f;
        if (isKK ? (mt >= nt) : (mt <= nt)) {
            LAS unsigned char* Bb = isKK ? (L + GO_KH) : (L + GO_QH);
#pragma unroll
            for (int k = 0; k < 8; ++k) acc2 = MFMA32(ldfrag(L + GO_KH, mt * 32 + r32, PQ, k * 32 + hi * 16), ldfrag(Bb, nt * 32 + r32, PQ, k * 32 + hi * 16), acc2);
        }
        __syncthreads();
        RELAUNDER();
        if (isKK) {
            const int j = nt * 32 + r32; const float gcj = SCb[64 + j], rkj = SCb[320 + j];
#pragma unroll
            for (int r = 0; r < 16; ++r) { const int i = mt * 32 + (r & 3) + 8 * (r >> 2) + 4 * hi;
                const float val = (i > j) ? SCb[i] * SCb[320 + i] * rkj * acc2[r] * fexp(SCb[64 + i] - gcj) : 0.f; Lf[i * LP + j] = val; acc2[r] = val; }
            if (mt == nt) { LAS float* LT = (LAS float*)(L + GO_T1) + (mt * 2 + (r32 >> 4)) * 256 + (r32 & 15) * 16;
                const bool up = r32 >= 16;
#pragma unroll
                for (int g2 = 0; g2 < 2; ++g2) *(LAS f32x4*)(LT + 8 * g2 + 4 * hi) = (f32x4){up ? acc2[8 + g2 * 4] : acc2[g2 * 4], up ? acc2[9 + g2 * 4] : acc2[1 + g2 * 4], up ? acc2[10 + g2 * 4] : acc2[2 + g2 * 4], up ? acc2[11 + g2 * 4] : acc2[3 + g2 * 4]}; }
        } else {
            const int i = nt * 32 + r32; const float gci = SCb[64 + i], rqi = SCb[256 + i];
#pragma unroll
            for (int rg = 0; rg < 4; ++rg) { const int j0 = mt * 32 + 8 * rg + 4 * hi; float z[4];
#pragma unroll
                for (int q = 0; q < 4; ++q) { const int j = j0 + q; z[q] = (i >= j) ? rqi * SCb[320 + j] * acc2[rg * 4 + q] * fexp(gci - SCb[64 + j]) : 0.f; }
                *(v2u*)(AiBuf + ((size_t)unit * 64 + i) * 64 + j0) = (v2u){pk2(z[0], z[1]), pk2(z[2], z[3])}; }
        }
        if (tid < 192) ScBuf[(size_t)unit * 192 + tid] = SCb[tid < 64 ? 384 + tid : (tid < 128 ? 448 + (tid - 64) : 128 + (tid - 128))];
        __syncthreads();
        }
        { REOPQ();
        if (wave == 0) { const int b16 = lane >> 4, c = lane & 15; const LAS float* LT = (const LAS float*)(L + GO_T1) + b16 * 256; float s[16];
#pragma unroll
            for (int i = 0; i < 16; ++i) s[i] = (i == c) ? 1.f : 0.f;
#pragma unroll
            for (int j = 0; j < 15; ++j) { const float xj = s[j];
#pragma unroll
                for (int q = (j + 1) / 4; q < 4; ++q) { const f32x4 l4 = *(const LAS f32x4*)(LT + j * 16 + q * 4);
                    if (q * 4 + 0 > j) s[q * 4 + 0] -= l4.x * xj;
                    if (q * 4 + 1 > j) s[q * 4 + 1] -= l4.y * xj;
                    if (q * 4 + 2 > j) s[q * 4 + 2] -= l4.z * xj;
                    if (q * 4 + 3 > j) s[q * 4 + 3] -= l4.w * xj; } }
#pragma unroll
            for (int i = 0; i < 16; ++i) Lf[(b16 * 16 + i) * LP + b16 * 16 + c] = s[i];
        }
        __syncthreads();
        { const int B = tid >> 8, i = (tid >> 4) & 15, c = tid & 15; float m = 0.f;
#pragma unroll
            for (int q = 0; q < 4; ++q) { const f32x4 l4 = *(const LAS f32x4*)(Lf + (B * 32 + 16 + i) * LP + B * 32 + q * 4);
#pragma unroll
                for (int k = 0; k < 4; ++k) m += l4[k] * Lf[(B * 32 + q * 4 + k) * LP + B * 32 + c]; }
            Lf[(B * 32 + i) * LP + B * 32 + 16 + c] = m; }
        __syncthreads();
        { const int B = tid >> 8, i = (tid >> 4) & 15, c = tid & 15; float a = 0.f;
#pragma unroll
            for (int q = 0; q < 4; ++q) { const f32x4 t4 = *(const LAS f32x4*)(Lf + (B * 32 + 16 + i) * LP + B * 32 + 16 + q * 4);
#pragma unroll
                for (int k = 0; k < 4; ++k) a -= t4[k] * Lf[(B * 32 + q * 4 + k) * LP + B * 32 + 16 + c]; }
            Lf[(B * 32 + 16 + i) * LP + B * 32 + c] = a; }
        __syncthreads();
        { const int i = tid >> 4, c2 = (tid & 15) * 2; float m0 = 0.f, m1 = 0.f;
          typedef float f32x2_ __attribute__((ext_vector_type(2)));
#pragma unroll
            for (int q = 0; q < 8; ++q) { const f32x4 l4 = *(const LAS f32x4*)(Lf + (32 + i) * LP + q * 4);
#pragma unroll
                for (int k = 0; k < 4; ++k) { f32x2_ t = *(const LAS f32x2_*)(Lf + (q * 4 + k) * LP + c2);
                    if (q * 4 + k < 16 && c2 >= 16) t = (f32x2_){0.f, 0.f};
                    m0 += l4[k] * t.x; m1 += l4[k] * t.y; } }
            *(LAS f32x2_*)(Lf + i * LP + 32 + c2) = (f32x2_){m0, m1}; }
        __syncthreads();
        { const int i = tid >> 4, c2 = (tid & 15) * 2; float a0 = 0.f, a1 = 0.f;
          typedef float f32x2_ __attribute__((ext_vector_type(2)));
#pragma unroll
            for (int q = 0; q < 8; ++q) { const f32x4 t4 = *(const LAS f32x4*)(Lf + (32 + i) * LP + 32 + q * 4);
#pragma unroll
                for (int k = 0; k < 4; ++k) { const f32x2_ m = *(const LAS f32x2_*)(Lf + (q * 4 + k) * LP + 32 + c2);
                    const float tk = (q * 4 + k >= 16 && i < 16) ? 0.f : t4[k];
                    a0 -= tk * m.x; a1 -= tk * m.y; } }
            *(LAS f32x2_*)(Lf + (32 + i) * LP + c2) = (f32x2_){a0, a1}; }
        __syncthreads();
        { const int i = tid >> 3, j0 = (tid & 7) * 8; float z1[8], z2[8];
#pragma unroll
            for (int q = 0; q < 8; ++q) { const int j = j0 + q; const float t = (j > i) ? 0.f : Lf[i * LP + j]; z1[q] = t * SCb[j]; z2[q] = t * SCb[512 + j]; }
            *(LAS v4u*)(L + GO_T1 + i * PT + j0 * 2) = pack8(z1); *(LAS v4u*)(L + GO_T2 + i * PT + j0 * 2) = pack8(z2); }
        __syncthreads();
        }
        { REOPQ();
        f32x16_t accU, accW;
#pragma unroll
        for (int r = 0; r < 16; ++r) { accU[r] = 0.f; accW[r] = 0.f; }
#pragma unroll
        for (int k = 0; k < 4; ++k) {
            accU = MFMA32(ldfrag(L + GO_T1, mi * 32 + r32, PT, k * 32 + hi * 16), ldfrag(L + GO_VT, ne * 32 + r32, PT, k * 32 + hi * 16), accU);
            accW = MFMA32(ldfrag(L + GO_KT, md * 32 + r32, PT, k * 32 + hi * 16), ldfrag(L + GO_T2, nh * 32 + r32, PT, k * 32 + hi * 16), accW);
        }
        { bf16* yp = Y + t0 * NY + 512 + h * 128 + ne * 32 + r32;
#pragma unroll
          for (int r = 0; r < 16; ++r) { const int i = mi * 32 + (r & 3) + 8 * (r >> 2) + 4 * hi; yp[(size_t)i * NY] = (bf16)f2bf(accU[r]); } }
        { const int i = nh * 32 + r32;
#pragma unroll
          for (int rg = 0; rg < 4; ++rg) { const int d0 = md * 32 + 8 * rg + 4 * hi;
              *(v2u*)(U + (t0 + i) * NU + U_GV + h * 128 + d0) = (v2u){pk2(-accW[rg * 4], -accW[rg * 4 + 1]), pk2(-accW[rg * 4 + 2], -accW[rg * 4 + 3])}; } }
        if (next_unit < 16 * (SEQ / 64)) {
            const int bh2 = next_unit >> 7, n2 = next_unit & 127, b2 = bh2 >> 2, h2 = bh2 & 3; const size_t t2 = (size_t)b2 * SEQ + (size_t)n2 * 64;
            const int ucol2 = gi < 16 ? U_GQ + h2 * 128 + gi * 8 : (gi < 32 ? U_GK + h2 * 128 + (gi - 16) * 8 : U_GV + h2 * 128 + (gi - 32) * 8);
            if (tid < 384) { const bf16* src = U + (t2 + run * 8) * NU + ucol2;
#pragma unroll
                for (int ii = 0; ii < 8; ++ii) pre[ii] = *(const v4u*)(src + (size_t)ii * NU); }
            if (wave == 7) { const float* gb = GBA + (t2 + lane) * 8; pgb0 = gb[h2]; pgb1 = gb[4 + h2]; } }
        __syncthreads();
        }
#undef REOPQ
#undef RELAUNDER
}

__device__ __forceinline__ void gdn_seq(LAS unsigned char* L, int bh, const bf16* U, bf16* Y, const bf16* AiBuf, const float* ScBuf) {
    const TI F = ti(); const int tid0 = F.tid, wave = F.wave;
    const int b = bh >> 2, h = bh & 3;
    LAS float* SCb = (LAS float*)(L + GO_SC);
    f32x16_t accS0, accS1;
#pragma unroll
    for (int r = 0; r < 16; ++r) { accS0[r] = 0.f; accS1[r] = 0.f; }
    { unsigned z = 0u; asm volatile("" : "+v"(z));
      for (int idx = tid0; idx < 34816 / 16; idx += NTHR) *(LAS v4u*)(L + GO_ST + idx * 16) = (v4u){z, z, z, z}; }
    __syncthreads();
    const int mi = wave >> 2, ne = wave & 3, md = wave >> 1, nh = wave & 1;
    v4u pq[2], pw[2], pk[2], pa; bf16 pu[16]; float psc = 0.f;
#define GDN_SEQ_LOADS(T0, UNIT) do { \
        _Pragma("unroll") for (int k_ = 0; k_ < 2; ++k_) { const int it_ = tid_l + NTHR * k_, row_ = it_ >> 4, g_ = it_ & 15; \
            pq[k_] = *(const v4u*)(U + ((T0) + row_) * NU + U_GQ + h * 128 + g_ * 8); \
            pw[k_] = *(const v4u*)(U + ((T0) + row_) * NU + U_GV + h * 128 + g_ * 8); \
            pk[k_] = *(const v4u*)(U + ((T0) + row_) * NU + U_GK + h * 128 + g_ * 8); } \
        pa = *(const v4u*)(AiBuf + ((size_t)(UNIT) * 64 + (tid_l >> 3)) * 64 + (tid_l & 7) * 8); \
        { const bf16* yp_ = Y + (T0) * NY + 512 + h * 128 + ne * 32 + (tid_l & 31); \
          _Pragma("unroll") for (int r_ = 0; r_ < 16; ++r_) pu[r_] = yp_[(size_t)(mi * 32 + (r_ & 3) + 8 * (r_ >> 2) + 4 * ((tid_l >> 5) & 1)) * NY]; } \
        if (tid_l < 192) psc = ScBuf[(size_t)(UNIT) * 192 + tid_l]; } while (0)
    { const int tid_l = tid0; GDN_SEQ_LOADS((size_t)b * SEQ, bh * 128); }
#pragma unroll 1
    for (int n = 0; n < SEQ / 64; ++n) {
        const size_t t0 = (size_t)b * SEQ + (size_t)n * 64;
#define REOPQ() int tid = tid0; asm volatile("" : "+v"(tid)); const int lane = tid & 63; int r32 = lane & 31, hi = lane >> 5; (void)lane; (void)r32; (void)hi
#define RELAUNDER() asm volatile("" : "+v"(r32), "+v"(hi))
        { REOPQ();
#pragma unroll
        for (int k = 0; k < 2; ++k) { const int it = tid + NTHR * k, row = it >> 4, g = it & 15;
            *(LAS v4u*)(L + GO_QH + row * PQ + g * 16) = pq[k];
            *(LAS v4u*)(L + GO_LF + row * PQ + g * 16) = pw[k];
            *(LAS v4u*)(L + GO_KT + (2 * row + (g >> 3)) * PT + (g & 7) * 16) = pk[k]; }
        *(LAS v4u*)(L + GO_KH + (tid >> 3) * PT + (tid & 7) * 16) = pa;
        if (tid < 192) SCb[tid < 64 ? 384 + tid : (tid < 128 ? 448 + (tid - 64) : 128 + (tid - 128))] = psc;
        f32x16_t accU;
#pragma unroll
        for (int r = 0; r < 16; ++r) accU[r] = bf1(pu[r]);
        if (n + 1 < SEQ / 64) { const int tid_l = tid; GDN_SEQ_LOADS(t0 + 64, bh * 128 + n + 1); }
        __syncthreads();
        RELAUNDER();
        f32x16_t accO;
#pragma unroll
        for (int r = 0; r < 16; ++r) accO[r] = 0.f;
#pragma unroll
        for (int k = 0; k < 8; ++k) { const bf16x8_t bq = ldfrag(L + GO_ST, ne * 32 + r32, PQ, k * 32 + hi * 16);
            accU = MFMA32(ldfrag(L + GO_LF, mi * 32 + r32, PQ, k * 32 + hi * 16), bq, accU);
            accO = MFMA32(ldfrag(L + GO_QH, mi * 32 + r32, PQ, k * 32 + hi * 16), bq, accO);
            if ((k & 3) == 3) __builtin_amdgcn_sched_barrier(0); }
        { const int e = ne * 32 + r32;
#pragma unroll
          for (int rg = 0; rg < 4; ++rg) { const int i0 = mi * 32 + 8 * rg + 4 * hi;
              const f32x4 eg4 = *(const LAS f32x4*)(SCb + 384 + i0), dl4 = *(const LAS f32x4*)(SCb + 448 + i0);
              const float v0 = accU[rg * 4], v1 = accU[rg * 4 + 1], v2 = accU[rg * 4 + 2], v3 = accU[rg * 4 + 3];
              accO[rg * 4] *= eg4.x; accO[rg * 4 + 1] *= eg4.y; accO[rg * 4 + 2] *= eg4.z; accO[rg * 4 + 3] *= eg4.w;
              *(LAS v2u*)(L + GO_T1 + e * PT + i0 * 2) = (v2u){pk2(v0, v1), pk2(v2, v3)};
              *(LAS v2u*)(L + GO_VT + e * PT + i0 * 2) = (v2u){pk2(v0 * dl4.x, v1 * dl4.y), pk2(v2 * dl4.z, v3 * dl4.w)}; } }
        __syncthreads();
        RELAUNDER();
#pragma unroll
        for (int k = 0; k < 4; ++k) accO = MFMA32(ldfrag(L + GO_KH, mi * 32 + r32, PT, k * 32 + hi * 16), ldfrag(L + GO_T1, ne * 32 + r32, PT, k * 32 + hi * 16), accO);
        { bf16* yp = Y + t0 * NY + 512 + h * 128 + ne * 32 + r32;
#pragma unroll
          for (int r = 0; r < 16; ++r) { const int i = mi * 32 + (r & 3) + 8 * (r >> 2) + 4 * hi; yp[(size_t)i * NY] = (bf16)f2bf(accO[r]); } }
        { const float gL = SCb[128 + 63];
#pragma unroll
          for (int r = 0; r < 16; ++r) { accS0[r] *= gL; accS1[r] *= gL; }
#pragma unroll
          for (int k = 0; k < 4; ++k) { const bf16x8_t a = ldfrag(L + GO_KT, md * 32 + r32, PT, k * 32 + hi * 16);
              accS0 = MFMA32(a, ldfrag(L + GO_VT, (2 * nh) * 32 + r32, PT, k * 32 + hi * 16), accS0);
              accS1 = MFMA32(a, ldfrag(L + GO_VT, (2 * nh + 1) * 32 + r32, PT, k * 32 + hi * 16), accS1); }
#pragma unroll
          for (int rg = 0; rg < 4; ++rg) { const int d0 = md * 32 + 8 * rg + 4 * hi;
              *(LAS v2u*)(L + GO_ST + ((2 * nh) * 32 + r32) * PQ + d0 * 2) = (v2u){pk2(accS0[rg * 4], accS0[rg * 4 + 1]), pk2(accS0[rg * 4 + 2], accS0[rg * 4 + 3])};
              *(LAS v2u*)(L + GO_ST + ((2 * nh + 1) * 32 + r32) * PQ + d0 * 2) = (v2u){pk2(accS1[rg * 4], accS1[rg * 4 + 1]), pk2(accS1[rg * 4 + 2], accS1[rg * 4 + 3])}; } }
        __syncthreads();
        }
    }
#undef REOPQ
#undef RELAUNDER
#undef GDN_SEQ_LOADS
}

__device__ __forceinline__ void combine_phase(int l, const float* lp, const float* sublnw, const float* gnw, const bf16* OP, const bf16* U, bf16* Y) {
    const TI F = ti();
    const float lambda_init = l == 0 ? 0.2f : 0.35550906759f;
    const float s01 = wave_sum(lp[F.lane] * lp[64 + F.lane]), s23 = wave_sum(lp[128 + F.lane] * lp[192 + F.lane]);
    const float lam = fexp(s01) - fexp(s23) + lambda_init;
    const int hh = F.lane >> 4, j = F.lane & 15;
    float sw[8], gw_[8];
    { const f32x4 a = *(const f32x4*)(sublnw + j * 8), b = *(const f32x4*)(sublnw + j * 8 + 4);
      sw[0] = a.x; sw[1] = a.y; sw[2] = a.z; sw[3] = a.w; sw[4] = b.x; sw[5] = b.y; sw[6] = b.z; sw[7] = b.w;
      const f32x4 c = *(const f32x4*)(gnw + j * 8), d = *(const f32x4*)(gnw + j * 8 + 4);
      gw_[0] = c.x; gw_[1] = c.y; gw_[2] = c.z; gw_[3] = c.w; gw_[4] = d.x; gw_[5] = d.y; gw_[6] = d.z; gw_[7] = d.w; }
    const int gw = obid() * NWAVES + F.wave, NGW = F.G * NWAVES;
    for (int row = gw; row < M; row += NGW) {
        float o0[8], o1[8], z[8], og[8], zg[8];
        unpack8(*(const v4u*)(OP + (size_t)row * 1024 + hh * 256 + j * 8), o0);
        unpack8(*(const v4u*)(OP + (size_t)row * 1024 + hh * 256 + 128 + j * 8), o1);
        unpack8(*(const v4u*)(U + (size_t)row * NU + U_AZ + hh * 128 + j * 8), z);
        unpack8(*(const v4u*)(Y + (size_t)row * NY + 512 + hh * 128 + j * 8), og);
        unpack8(*(const v4u*)(U + (size_t)row * NU + U_GZ + hh * 128 + j * 8), zg);
        float ss = 0.f, sg = 0.f;
#pragma unroll
        for (int c = 0; c < 8; ++c) { o0[c] = o0[c] - lam * o1[c]; ss += o0[c] * o0[c]; sg += og[c] * og[c]; }
#pragma unroll
        for (int o = 1; o < 16; o <<= 1) { ss += __shfl_xor(ss, o); sg += __shfl_xor(sg, o); }
        const float ra = rsqrtf(ss * (1.0f / 128.0f) + 1e-5f) * (1.0f - lambda_init), rg = rsqrtf(sg * (1.0f / 128.0f) + 1e-6f);
        float ya[8], yg[8];
#pragma unroll
        for (int c = 0; c < 8; ++c) { ya[c] = o0[c] * ra * sw[c] * (z[c] * sigmoidf_(z[c])); yg[c] = og[c] * rg * gw_[c] * (zg[c] * sigmoidf_(zg[c])); }
        v4u wa, wg2; wa.x = pk2(ya[0], ya[1]); wa.y = pk2(ya[2], ya[3]); wa.z = pk2(ya[4], ya[5]); wa.w = pk2(ya[6], ya[7]);
        wg2.x = pk2(yg[0], yg[1]); wg2.y = pk2(yg[2], yg[3]); wg2.z = pk2(yg[4], yg[5]); wg2.w = pk2(yg[6], yg[7]);
        *(v4u*)(Y + (size_t)row * NY + hh * 128 + j * 8) = wa;
        *(v4u*)(Y + (size_t)row * NY + 512 + hh * 128 + j * 8) = wg2;
    }
}

#define XB_TMO      128
#define XB_XCNT(j)  (256  + 64 * (j))
#define XB_XSUB(j)  (1280 + 64 * (j))
#define XB_XGEN(j)  (2304 + 64 * (j))
#define XB_TOP      3328
#define XB_TOPGEN   3392
#define XCD_BAR_WORDS 3456
#define XB_SPIN_CAP (1u << 18)

__device__ __forceinline__ unsigned xb_ld(unsigned* p)              { return __hip_atomic_load(p, __ATOMIC_RELAXED, __HIP_MEMORY_SCOPE_AGENT); }
__device__ __forceinline__ unsigned xb_add(unsigned* p, unsigned v) { return __hip_atomic_fetch_add(p, v, __ATOMIC_RELAXED, __HIP_MEMORY_SCOPE_AGENT); }
__device__ __forceinline__ unsigned xb_xcc_id() { return (unsigned)__builtin_amdgcn_s_getreg((3 << 11) | 20) & 0xFu; }
#define XB_SPIN(cond, bar) do { unsigned _sp = 0; while (cond) { __builtin_amdgcn_s_sleep(1); \
    if ((++_sp & 255u) == 0u) { if (xb_ld(&(bar)[XB_TMO])) break; if (_sp > XB_SPIN_CAP) { atomicAdd(&(bar)[XB_TMO], 1u); break; } } } } while (0)

struct XcdBarrier {
    unsigned* bar; unsigned x;
    volatile LAS unsigned* st;
};

__device__ __forceinline__ XcdBarrier xcd_barrier_post(unsigned* bar, volatile LAS unsigned* st) {
    XcdBarrier b; b.bar = bar; b.x = xb_xcc_id(); b.st = st;
    if (threadIdx.x == 0) (void)xb_add(&bar[XB_XCNT(b.x)], 1u);
    return b;
}
__device__ __forceinline__ void xcd_barrier_complete(unsigned* bar, unsigned x, unsigned& nloc, unsigned& nx) {
    const unsigned G = gridDim.x * gridDim.y * gridDim.z;
    unsigned sum, cnt, mine, sp = 0u;
    for (;;) {
        sum = 0u; cnt = 0u; mine = 0u;
#pragma unroll
        for (unsigned j = 0; j < 16; ++j) { const unsigned c = xb_ld(&bar[XB_XCNT(j)]); sum += c; cnt += (c > 0u) ? 1u : 0u; mine = (j == x) ? c : mine; }
        if (sum == G) break;
        __builtin_amdgcn_s_sleep(1);
        if ((++sp & 255u) == 0u) { if (xb_ld(&bar[XB_TMO])) break; if (sp > XB_SPIN_CAP) { atomicAdd(&bar[XB_TMO], 1u); break; } }
    }
    nloc = mine > 0u ? mine : 1u; nx = cnt > 0u ? cnt : 1u;
}

__device__ __forceinline__ void xcd_barrier(const XcdBarrier& b) {
    asm volatile("s_waitcnt vmcnt(0)" ::: "memory");
    __syncthreads();
    if (threadIdx.x == 0) {
        unsigned* bar = b.bar;
        __builtin_amdgcn_s_waitcnt(0);
        unsigned nloc = b.st[0], nx = b.st[1];
        if (nloc == 0u) { xcd_barrier_complete(bar, b.x, nloc, nx); b.st[0] = nloc; b.st[1] = nx; }
        const unsigned old = xb_add(&bar[XB_XSUB(b.x)], 1u);
        const unsigned gen = old / nloc;
        if (old + 1u == (gen + 1u) * nloc) {
            __builtin_amdgcn_fence(__ATOMIC_RELEASE, "agent");
            asm volatile("s_waitcnt vmcnt(0)" ::: "memory");
            const unsigned og = xb_add(&bar[XB_TOP], 1u);
            const unsigned tg = og / nx;
            if (og + 1u == (tg + 1u) * nx) xb_add(&bar[XB_TOPGEN], 1u);
            else XB_SPIN(xb_ld(&bar[XB_TOPGEN]) == tg, bar);
            __builtin_amdgcn_fence(__ATOMIC_ACQUIRE, "agent");
            xb_add(&bar[XB_XGEN(b.x)], 1u);
            asm volatile("s_waitcnt vmcnt(0)" ::: "memory");
        } else {
            XB_SPIN(xb_ld(&bar[XB_XGEN(b.x)]) == gen, bar);
            __builtin_amdgcn_fence(__ATOMIC_ACQUIRE, "agent");
            asm volatile("s_waitcnt vmcnt(0)" ::: "memory");
        }
    }
    __syncthreads();
}

constexpr size_t WS_BAR = 16384;
constexpr int XB_LDS_OFF = 147392;

#define WSP(off) (A->ws + (off))
#define GSYNC() do { KArgP A_ = kargs(); XcdBarrier b_; b_.bar = (unsigned*)(A_->ws + WS_BAR); b_.x = xb_xcc_id(); b_.st = (volatile LAS unsigned*)(L + XB_LDS_OFF); xcd_barrier(b_); } while (0)

template <int l> __device__ __forceinline__ void layer_body(LAS unsigned char* L, unsigned char* lds) {

        { KArgP A = kargs();
          pg8::Gemm g{(const bf16*)WSP(WS_XN), (const bf16*)WSP(WS_WIN) + (size_t)l * NU * DMODEL, M, NU, DMODEL, DMODEL}; pg8::StaticOrder S; S.init(M, NU, ogrid(), obid());
          pg8::EpiBf16<0> E{(bf16*)WSP(WS_U), NU, nullptr, 512, 512, ATT_C2};
          pg8::gemm_phase<pg8::EpiBf16<0>, pg8::StaticOrder, true, true>(L, g, S, E); }
        GSYNC();
        { KArgP A = kargs(); lru_conv_phase(A->in[9] + l * 4 * 512, A->in[10] + l * 512, (const bf16*)WSP(WS_U), (bf16*)WSP(WS_Y)); }
        { KArgP A = kargs(); gdn_halo_load(L, (const bf16*)WSP(WS_U)); }
        GSYNC();
        { KArgP A = kargs(); gdn_conv_inplace(L, (bf16*)WSP(WS_U), A->in[5] + l * 4 * 1536); }
        GSYNC();
        { KArgP A = kargs();
          pg8::Gemm g{(const bf16*)WSP(WS_Y) + 1024, (const bf16*)WSP(WS_WG) + (size_t)l * 1024 * 512, M, 1024, 512, NY}; pg8::StaticOrder S; S.init(M, 1024, ogrid(), obid());
          pg8::EpiGate E{(bf16*)WSP(WS_U) + U_RX, NU, (bf16*)WSP(WS_Y), NY, A->in[12] + l * 1024};
          pg8::gemm_phase<pg8::EpiGate, pg8::StaticOrder, true, true>(L, g, S, E); }
        { v4u pre[8]; float pgb0 = 0.f, pgb1 = 0.f;
#pragma unroll
          for (int ii = 0; ii < 8; ++ii) pre[ii] = (v4u){0u, 0u, 0u, 0u};
          { KArgP A = kargs(); const int u0 = obid(); const TI F = ti();
            if (u0 < 16 * (SEQ / 64)) { const int bh = u0 >> 7, n = u0 & 127, b = bh >> 2, h = bh & 3, gi = F.tid % 48, run = F.tid / 48; const size_t t0 = (size_t)b * SEQ + (size_t)n * 64;
                const int ucol = gi < 16 ? U_GQ + h * 128 + gi * 8 : (gi < 32 ? U_GK + h * 128 + (gi - 16) * 8 : U_GV + h * 128 + (gi - 32) * 8);
                if (F.tid < 384) { const bf16* src = (const bf16*)WSP(WS_U) + (t0 + run * 8) * NU + ucol;
#pragma unroll
                    for (int ii = 0; ii < 8; ++ii) pre[ii] = *(const v4u*)(src + (size_t)ii * NU); }
                if (F.wave == 7) { const float* gb = (const float*)WSP(WS_GBA) + (t0 + F.lane) * 8; pgb0 = gb[h]; pgb1 = gb[4 + h]; } } }
          for (int u = obid(); u < 16 * (SEQ / 64); u += ogrid()) { KArgP A = kargs();
            bf16* aib = (bf16*)(l == 0 ? (unsigned char*)A->out : WSP(WS_WIN)); float* scb = (float*)((unsigned char*)aib + 16 * MiB);
            gdn_prep(L, u, u + ogrid(), pre, pgb0, pgb1, A->in[6] + l * 4, A->in[7] + l * 4, (const float*)WSP(WS_GBA), (bf16*)WSP(WS_U), (bf16*)WSP(WS_Y), aib, scb); } }
        GSYNC();
        for (int g = obid(); g < N_GDN_UNITS; g += ogrid()) { KArgP A = kargs();
            const bf16* aib = (const bf16*)(l == 0 ? (unsigned char*)A->out : WSP(WS_WIN)); const float* scb = (const float*)((const unsigned char*)aib + 16 * MiB);
            gdn_seq(L, g, (const bf16*)WSP(WS_U), (bf16*)WSP(WS_Y), aib, scb); }

        for (;;) {
            volatile LAS int* MISC = (volatile LAS int*)(L + MISC_OFF);
            __syncthreads();
            if (otid() == 0) { KArgP A = kargs(); MISC[0] = (int)atomicAdd((unsigned*)WSP(WS_CTL) + 64 * (l + 1), 1u); }
            __syncthreads();
            const int w = __builtin_amdgcn_readfirstlane(MISC[0]);
            if (w >= N_LRU_UNITS + N_ATT_UNITS) break;
            KArgP A = kargs();
            if (w >= 384 && w < 384 + N_LRU_UNITS) {
                lru_unit(L, w - 384, A->in[13] + l * 512, (const bf16*)WSP(WS_U), (bf16*)WSP(WS_Y));
            } else {
                const int i = w < 384 ? w : w - N_LRU_UNITS, qb = 31 - (i >> 5), bhm = i & 31, b = bhm >> 3, hm = bhm & 7;
                typedef attn2::bf16 abf;
                const abf* U = (const abf*)WSP(WS_U); const size_t r0 = (size_t)b * SEQ;
                attn2::BlockRef<abf, abf> cur{U + (r0 + qb * 256) * NU + U_AQ + hm * 64, U + r0 * NU + U_AK + hm * 64, U + r0 * NU + U_AV + (hm >> 1) * 128,
                                              (abf*)WSP(WS_XN) + (r0 + qb * 256) * 1024 + hm * 128, qb * 256};
                attn2::Seam<abf> S;
                attn2::causal_swa_prime(cur, 1 << 30, (char*)lds, S);
                attn2::causal_swa_block(cur, cur, SEQ, 1 << 30, (char*)lds, S);
            }
        }
        GSYNC();
        { KArgP A = kargs(); combine_phase(l, A->in[3] + l * 256, A->in[4] + l * 128, A->in[8] + l * 128, (const bf16*)WSP(WS_XN), (const bf16*)WSP(WS_U), (bf16*)WSP(WS_Y)); }
        GSYNC();
        { KArgP A = kargs();
          pg8::Gemm g{(const bf16*)WSP(WS_Y), (const bf16*)WSP(WS_WOUT) + (size_t)l * DMODEL * NY, M, DMODEL, NY, NY}; pg8::StaticOrder S; S.init(M, DMODEL, ogrid(), obid());
          pg8::EpiRes E{l == 0 ? A->in[0] : (const float*)A->out, A->out, DMODEL};
          pg8::gemm_phase<pg8::EpiRes, pg8::StaticOrder, true, true>(L, g, S, E); }
        GSYNC();
        if (l == 0) { { KArgP A = kargs(); norm_phase(L, A->out, A->in[2] + (size_t)DMODEL * INC, A->in[1] + DMODEL, (bf16*)WSP(WS_XN), (float*)WSP(WS_GBA)); } GSYNC(); }
        else { KArgP A = kargs();
            final_norm_phase(A->out, A->in[15]);
        }

}

__global__ void __launch_bounds__(NTHR, 2) mega_fwd(Args args) {
    extern __shared__ __attribute__((aligned(16))) unsigned char lds[];
    LAS unsigned char* L = (LAS unsigned char*)lds;

    if (otid() < 2) ((volatile LAS unsigned*)(L + XB_LDS_OFF))[otid()] = 0u;
    { KArgP A = kargs(); if (obid() == 0) for (int i = otid(); i < 8192; i += NTHR) ((unsigned*)WSP(WS_CTL))[i] = 0u; }
    { KArgP A = kargs(); p0_weights(L, A->in[2], A->in[14], A->in[11], (bf16*)WSP(WS_WIN), (bf16*)WSP(WS_WOUT), (bf16*)WSP(WS_WG)); }
    __syncthreads();
    { KArgP A = kargs(); norm_phase(L, A->in[0], A->in[2], A->in[1], (bf16*)WSP(WS_XN), (float*)WSP(WS_GBA)); }
    cg::this_grid().sync();
    { KArgP A = kargs(); (void)xcd_barrier_post((unsigned*)(A->ws + WS_BAR), (volatile LAS unsigned*)(L + XB_LDS_OFF)); }

    layer_body<0>(L, lds);
    layer_body<1>(L, lds);
}

extern "C" void kernel_launch(void* const* d_in, const int* in_sizes, int n_in, void* d_out, int out_size, void* d_ws, size_t ws_size, hipStream_t stream) {
    static int grid = 0;
    if (grid == 0) {
        if (n_in != 16 || out_size != M * DMODEL || ws_size < WS_END) { fprintf(stderr, "kernel_launch: unexpected shapes (n_in %d out %d ws %zu)\n", n_in, out_size, ws_size); grid = -1; return; }
        int dev = 0, cus = 0, per_cu = 0;
        hipGetDevice(&dev); hipDeviceGetAttribute(&cus, hipDeviceAttributeMultiprocessorCount, dev);
        hipFuncSetAttribute((const void*)mega_fwd, hipFuncAttributeMaxDynamicSharedMemorySize, LDS_BYTES);
        hipOccupancyMaxActiveBlocksPerMultiprocessor(&per_cu, (const void*)mega_fwd, NTHR, LDS_BYTES);
        (void)hipGetLastError();
        if (per_cu < 1) { fprintf(stderr, "kernel_launch: occupancy query says %d blocks per CU\n", per_cu); per_cu = 1; }
        grid = cus;
    }
    if (grid < 0) return;
    Args a{};
    for (int i = 0; i < 16; ++i) a.in[i] = (const float*)d_in[i];
    a.out = (float*)d_out; a.ws = (unsigned char*)d_ws;
    void* kargs[] = {&a};
    hipError_t e = hipLaunchCooperativeKernel((const void*)mega_fwd, dim3(grid), dim3(NTHR), kargs, LDS_BYTES, stream);
    if (e != hipSuccess) fprintf(stderr, "cooperative launch failed: %s (grid %d)\n", hipGetErrorString(e), grid);
}
```

```cpp
#include <hip/hip_runtime.h>
#include <hip/hip_bf16.h>
#include <hip/hip_cooperative_groups.h>
#include <cstdio>
#include <cstdint>
#include <cstddef>
__device__ __forceinline__ int otid() { int t = threadIdx.x; asm volatile("" : "+v"(t)); return t; }
__device__ __forceinline__ int obid() { int t = blockIdx.x; asm volatile("" : "+s"(t)); return t; }
__device__ __forceinline__ int ogrid() { int t = gridDim.x; asm volatile("" : "+s"(t)); return t; }
namespace pg8 {
#define PG8_LAS __attribute__((address_space(3)))
typedef unsigned short bf16_t;
typedef short bf16x8 __attribute__((ext_vector_type(8)));
typedef float f32x4 __attribute__((ext_vector_type(4)));
typedef unsigned u32x4 __attribute__((ext_vector_type(4)));
constexpr int BM = 256, BK = 64, HALF = 128, HTB = HALF * BK * 2  , STAGE_BYTES = 8 * HTB, NXCD = 8, WGM = 8;

__host__ __device__ __forceinline__ int lds_byte(int r, int c) { const int st = (r >> 4) * 2 + (c >> 5), rr = r & 15, cc = c & 31, ob = rr * 64 + cc * 2; return st * 1024 + (ob ^ (((ob >> 9) & 1) << 5)); }
__host__ __device__ __forceinline__ void stage_rc(int b, int& R, int& C) { const int st = b / 1024, sb = b % 1024, swz = sb ^ (((sb >> 9) & 1) << 5); R = (st >> 1) * 16 + swz / 64; C = (st & 1) * 32 + (swz % 64) / 2; }
__host__ __device__ __forceinline__ int perm32(int rho) { const int n = rho >> 4, i = rho & 15; return 8 * (i >> 2) + 4 * n + (i & 3); }

struct Unit { int pm, pn; };
struct Gemm { const bf16_t* A; const bf16_t* Bt; int M, N, K, lda; };

struct StaticOrder {
    int nM, nN, nwg, G, c;
    __host__ __device__ void init(int M, int N, int G_, int c_) { nM = M / BM; nN = N / BM; nwg = nM * nN; G = G_; c = c_; }
    __host__ __device__ bool next(int i, Unit& u) const {
        const long L = (long)i * G + c; if (L >= nwg) return false;
        int wgid = (int)L; { const int q = nwg / NXCD, r = nwg % NXCD, xcd = wgid % NXCD, off = wgid / NXCD; wgid = (xcd < r ? xcd * (q + 1) : r * (q + 1) + (xcd - r) * q) + off; }
        const int nig = WGM * nN, gid = wgid / nig, fm = gid * WGM, gsz = (nM - fm) < WGM ? (nM - fm) : WGM;
        u.pm = fm + ((wgid % nig) % gsz); u.pn = (wgid % nig) / gsz; return true;
    }
    __device__ __forceinline__ void a_ready(const Unit&) const {}
    __device__ __forceinline__ void done(const Unit&) const {}
};

__device__ __forceinline__ unsigned cvt_pk_bf16(float lo, float hi) { unsigned r; asm volatile("v_cvt_pk_bf16_f32 %0, %1, %2" : "=v"(r) : "v"(lo), "v"(hi)); return r; }
typedef float f32x2 __attribute__((ext_vector_type(2)));
__device__ __forceinline__ f32x2 gelu_pk(f32x2 v) {
    const f32x2 av = __builtin_elementwise_abs(v), d = av * 0.2316418882f + 1.0f;
    f32x2 t; t.x = __builtin_amdgcn_rcpf(d.x); t.y = __builtin_amdgcn_rcpf(d.y);
    f32x2 q = t * 0.5307027145f + (-0.7265760135f); q = q * t + 0.7107068705f; q = q * t + (-0.142248368f); q = q * t + 0.127414796f; q = q * t;
    const f32x2 s = (v * v) * (-0.72134752044f);
    f32x2 e; e.x = __builtin_amdgcn_exp2f(s.x); e.y = __builtin_amdgcn_exp2f(s.y);
    const f32x2 m = v * (q * e), r = v - m;
    f32x2 o; o.x = v.x < 0.f ? m.x : r.x; o.y = v.y < 0.f ? m.y : r.y; return o;
}

template <int ACT  > struct EpiBf16 {
    static constexpr bool PERM = true, AFTER_DRAIN = false; static_assert(ACT == 0 || ACT == 1, "EpiBf16: ACT is 0 (none) or 1 (gelu_pk)");
    bf16_t* O; int ldc; const float* bias; int split_cols; size_t split_stride; float scale0;
    __device__ __forceinline__ void operator()(const f32x4 (&acc)[2][2][4][2], const Unit& u, int wr, int wc, int fr, int fq) const {
        const int row0 = u.pm * BM + wr * 64 + fr; int colt = u.pn * BM; bf16_t* base = O;
        float sc = 1.f; if (split_cols) { const int t = colt / split_cols; base += (size_t)t * split_stride; colt -= t * split_cols; if (t == 0) sc = scale0; }
        const int col0 = colt + wc * 32 + 8 * fq, bcol0 = u.pn * BM + wc * 32 + 8 * fq;
        f32x4 bv[2][2];
#pragma unroll
        for (int bj = 0; bj < 2; ++bj)
#pragma unroll
            for (int n = 0; n < 2; ++n) bv[bj][n] = bias ? *(const f32x4*)(bias + bcol0 + bj * HALF + 4 * n) : (f32x4){0.f, 0.f, 0.f, 0.f};
#pragma unroll
        for (int ai = 0; ai < 2; ++ai)
#pragma unroll
            for (int m = 0; m < 4; ++m) { bf16_t* rowp = base + (size_t)(row0 + ai * HALF + m * 16) * ldc + col0;
#pragma unroll
                for (int bj = 0; bj < 2; ++bj) { f32x4 v0 = acc[ai][bj][m][0] + bv[bj][0], v1 = acc[ai][bj][m][1] + bv[bj][1];
                    if (ACT == 1) { f32x2 a = gelu_pk((f32x2){v0[0], v0[1]}), b = gelu_pk((f32x2){v0[2], v0[3]}), c = gelu_pk((f32x2){v1[0], v1[1]}), d = gelu_pk((f32x2){v1[2], v1[3]});
                        v0 = (f32x4){a.x, a.y, b.x, b.y}; v1 = (f32x4){c.x, c.y, d.x, d.y}; }
                    v0 = v0 * sc; v1 = v1 * sc; u32x4 w; w.x = cvt_pk_bf16(v0[0], v0[1]); w.y = cvt_pk_bf16(v0[2], v0[3]); w.z = cvt_pk_bf16(v1[0], v1[1]); w.w = cvt_pk_bf16(v1[2], v1[3]);
                    *(u32x4*)(rowp + bj * HALF) = w; } }
    }
};
template <class Epi, class Sched, bool ALIGN_EPI = false, bool SP2 = false>
__device__ __forceinline__ void gemm_phase(PG8_LAS unsigned char* lds, const Gemm g, const Sched& S, const Epi& E) {
    const int tid = otid(), wid = __builtin_amdgcn_readfirstlane(tid >> 6), lane = tid & 63, wr = wid >> 2, wc = wid & 3, fr = lane & 15, fq = lane >> 4;
    const int K = g.K, nt = K / BK;
    unsigned voffA[2], voffB[2];
#pragma unroll
    for (int i = 0; i < 2; ++i) { int R, C; stage_rc(tid * 16 + i * 8192, R, C); const int Rb = Epi::PERM ? ((R & ~31) + perm32(R & 31)) : R;
        voffA[i] = (unsigned)(R * g.lda + C) * 2u; voffB[i] = (unsigned)(Rb * K + C) * 2u; }
    const size_t kstep = (size_t)(BK * 2);
    const size_t hstepB = (size_t)HALF * K * 2; const size_t hstepA = (size_t)HALF * g.lda * 2;
    const size_t tstepA = 2 * hstepA; const size_t tstepB = 2 * hstepB;
    const unsigned ldsw = (unsigned)wid * 1024u;
    const int aoff = lds_byte(wr * 64 + fr, fq * 8), boff = lds_byte(wc * 32 + fr, fq * 8);
#define PG8_SA(b, h) (((b) * 2 + (h)) * HTB)
#define PG8_SB(b, h) ((4 + (b) * 2 + (h)) * HTB)
#define PG8_STAGE(bufoff, gbase, voff) do { _Pragma("unroll") for (int _i = 0; _i < 2; ++_i) \
        __builtin_amdgcn_global_load_lds((const unsigned*)((const char*)(gbase) + (voff)[_i]), (PG8_LAS unsigned*)(lds + (bufoff) + ldsw + _i * 8192), 16, 0, 0); } while (0)
#define PG8_LDA(dst, b, h) do { _Pragma("unroll") for (int m = 0; m < 4; ++m) _Pragma("unroll") for (int k = 0; k < 2; ++k) dst[m][k] = *(const PG8_LAS bf16x8*)(lds + PG8_SA(b, h) + aoff + m * 2048 + k * 1024); } while (0)
#define PG8_LDB(dst, b, h) do { _Pragma("unroll") for (int n = 0; n < 2; ++n) _Pragma("unroll") for (int k = 0; k < 2; ++k) dst[n][k] = *(const PG8_LAS bf16x8*)(lds + PG8_SB(b, h) + boff + n * 2048 + k * 1024); } while (0)
#define PG8_MMA(ai, bj, At, Bt) do { __builtin_amdgcn_s_setprio(1); _Pragma("unroll") for (int m = 0; m < 4; ++m) _Pragma("unroll") for (int n = 0; n < 2; ++n) _Pragma("unroll") for (int k = 0; k < 2; ++k) \
        acc[ai][bj][m][n] = __builtin_amdgcn_mfma_f32_16x16x32_bf16(Bt[n][k], At[m][k], acc[ai][bj][m][n], 0, 0, 0); __builtin_amdgcn_s_setprio(0); } while (0)
#define PG8_WAIT_V(n) asm volatile("s_waitcnt vmcnt(" #n ")" ::: "memory")
#define PG8_WAIT_L(n) asm volatile("s_waitcnt lgkmcnt(" #n ")" ::: "memory")
#define PG8_BAR __builtin_amdgcn_s_barrier()
#define PG8_SCHED __builtin_amdgcn_sched_barrier(0)
    Unit cur, nxt; int ui = 0;
    if (!S.next(0, cur)) return;
    f32x4 acc[2][2][4][2];
#pragma unroll
    for (int a = 0; a < 2; ++a)
#pragma unroll
        for (int b = 0; b < 2; ++b)
#pragma unroll
            for (int m = 0; m < 4; ++m)
#pragma unroll
                for (int n = 0; n < 2; ++n) acc[a][b][m][n] = (f32x4){0.f, 0.f, 0.f, 0.f};
    bf16x8 At[4][2], B0[2][2], B1[2][2];
    const char* cA = (const char*)g.A + (size_t)cur.pm * tstepA; const char* cB = (const char*)g.Bt + (size_t)cur.pn * tstepB;
    S.a_ready(cur);
    if constexpr (SP2) {
        PG8_STAGE(PG8_SB(0, 0), cB, voffB); PG8_STAGE(PG8_SB(0, 1), cB + hstepB, voffB); PG8_STAGE(PG8_SA(0, 0), cA, voffA); PG8_STAGE(PG8_SA(0, 1), cA + hstepA, voffA);
        if (wr == 1) PG8_BAR;
        PG8_WAIT_V(2); PG8_BAR;
        PG8_STAGE(PG8_SB(1, 0), cB + kstep, voffB); PG8_STAGE(PG8_SA(1, 0), cA + kstep, voffA); PG8_STAGE(PG8_SB(1, 1), cB + hstepB + kstep, voffB);
        PG8_WAIT_V(6); PG8_BAR;
    } else {
        PG8_STAGE(PG8_SB(0, 0), cB, voffB); PG8_STAGE(PG8_SA(0, 0), cA, voffA); PG8_STAGE(PG8_SB(0, 1), cB + hstepB, voffB); PG8_STAGE(PG8_SA(0, 1), cA + hstepA, voffA);
        if (wr == 1) PG8_BAR;
        PG8_WAIT_V(4); PG8_BAR;
        PG8_STAGE(PG8_SB(1, 0), cB + kstep, voffB); PG8_STAGE(PG8_SA(1, 0), cA + kstep, voffA); PG8_STAGE(PG8_SB(1, 1), cB + hstepB + kstep, voffB);
        PG8_WAIT_V(6); PG8_BAR;
    }
    for (;;) {
        const bool has_next = S.next(ui + 1, nxt);
        const char* nA = has_next ? (const char*)g.A + (size_t)nxt.pm * tstepA : cA; const char* nB = has_next ? (const char*)g.Bt + (size_t)nxt.pn * tstepB : cB;
        for (int t = 0; t < nt; t += 2) {
            const bool last = (t == nt - 2);
            const char* a1 = cA + (size_t)(t + 1) * kstep;
            const char* a2 = last ? nA : cA + (size_t)(t + 2) * kstep; const char* b2 = last ? nB : cB + (size_t)(t + 2) * kstep;
            const char* a3 = a2 + kstep; const char* b3 = b2 + kstep;
            if (last && has_next) S.a_ready(nxt);
            if constexpr (SP2) {
            PG8_LDB(B0, 0, 0); PG8_LDB(B1, 0, 1); PG8_SCHED; PG8_LDA(At, 0, 0); PG8_STAGE(PG8_SA(1, 1), a1 + hstepA, voffA);
            PG8_WAIT_V(8); PG8_WAIT_L(0); PG8_BAR; PG8_MMA(0, 0, At, B0); PG8_MMA(0, 1, At, B1); PG8_BAR; PG8_SCHED;
            PG8_LDA(At, 0, 1); PG8_STAGE(PG8_SB(0, 0), b2, voffB); PG8_STAGE(PG8_SB(0, 1), b2 + hstepB, voffB); PG8_STAGE(PG8_SA(0, 0), a2, voffA);
            PG8_WAIT_V(8); PG8_WAIT_L(0); PG8_BAR; PG8_MMA(1, 0, At, B0); PG8_MMA(1, 1, At, B1); PG8_BAR; PG8_SCHED;
            PG8_LDB(B0, 1, 0); PG8_LDB(B1, 1, 1); PG8_SCHED; PG8_LDA(At, 1, 0); PG8_STAGE(PG8_SA(0, 1), a2 + hstepA, voffA);
            PG8_WAIT_V(8); PG8_WAIT_L(0); PG8_BAR; PG8_MMA(0, 0, At, B0); PG8_MMA(0, 1, At, B1); PG8_BAR; PG8_SCHED;
            PG8_LDA(At, 1, 1); PG8_STAGE(PG8_SB(1, 0), b3, voffB); PG8_STAGE(PG8_SB(1, 1), b3 + hstepB, voffB); PG8_STAGE(PG8_SA(1, 0), a3, voffA);
            PG8_WAIT_V(8); PG8_WAIT_L(0); PG8_BAR; PG8_MMA(1, 0, At, B0); PG8_MMA(1, 1, At, B1); PG8_BAR; PG8_SCHED;
            } else {
            PG8_LDB(B0, 0, 0); PG8_SCHED; PG8_LDA(At, 0, 0); PG8_STAGE(PG8_SA(1, 1), a1 + hstepA, voffA);
            PG8_WAIT_L(8); PG8_BAR; PG8_WAIT_L(0); PG8_MMA(0, 0, At, B0); PG8_BAR; PG8_SCHED;
            PG8_LDB(B1, 0, 1); PG8_STAGE(PG8_SB(0, 0), b2, voffB);
            PG8_BAR; PG8_WAIT_L(0); PG8_MMA(0, 1, At, B1); PG8_BAR;
            PG8_LDA(At, 0, 1); PG8_STAGE(PG8_SA(0, 0), a2, voffA);
            PG8_BAR; PG8_WAIT_L(0); PG8_MMA(1, 0, At, B0); PG8_BAR; PG8_SCHED;
            PG8_STAGE(PG8_SB(0, 1), b2 + hstepB, voffB);
            PG8_WAIT_V(6); PG8_BAR; PG8_MMA(1, 1, At, B1); PG8_BAR;
            PG8_LDB(B0, 1, 0); PG8_SCHED; PG8_LDA(At, 1, 0); PG8_STAGE(PG8_SA(0, 1), a2 + hstepA, voffA);
            PG8_WAIT_L(8); PG8_BAR; PG8_WAIT_L(0); PG8_MMA(0, 0, At, B0); PG8_BAR; PG8_SCHED;
            PG8_LDB(B1, 1, 1); PG8_STAGE(PG8_SB(1, 0), b3, voffB);
            PG8_BAR; PG8_WAIT_L(0); PG8_MMA(0, 1, At, B1); PG8_BAR;
            PG8_LDA(At, 1, 1); PG8_STAGE(PG8_SA(1, 0), a3, voffA);
            PG8_BAR; PG8_WAIT_L(0); PG8_MMA(1, 0, At, B0); PG8_BAR; PG8_SCHED;
            PG8_STAGE(PG8_SB(1, 1), b3 + hstepB, voffB);
            PG8_WAIT_V(6); PG8_BAR; PG8_MMA(1, 1, At, B1); PG8_BAR;
            }
        }
        if constexpr (ALIGN_EPI) { if (wr == 0) PG8_BAR; }
        if constexpr (!Epi::AFTER_DRAIN) { E(acc, cur, wr, wc, fr, fq); S.done(cur); }
        if (!has_next) break;
#pragma unroll
        for (int a = 0; a < 2; ++a)
#pragma unroll
            for (int b = 0; b < 2; ++b)
#pragma unroll
                for (int m = 0; m < 4; ++m)
#pragma unroll
                    for (int n = 0; n < 2; ++n) acc[a][b][m][n] = (f32x4){0.f, 0.f, 0.f, 0.f};
        cur = nxt; cA = nA; cB = nB; ++ui;
        if constexpr (ALIGN_EPI) { if (wr == 1) PG8_BAR; }
    }
    PG8_WAIT_V(0);
    if constexpr (!ALIGN_EPI) { if (wr == 0) PG8_BAR; }
    PG8_BAR;
    if constexpr (Epi::AFTER_DRAIN) { E.fused(acc, cur, wr, wc, fr, fq, lds, wid, lane); S.done(cur); }
#undef PG8_SA
#undef PG8_SB
#undef PG8_STAGE
#undef PG8_LDA
#undef PG8_LDB
#undef PG8_MMA
#undef PG8_WAIT_V
#undef PG8_WAIT_L
#undef PG8_BAR
#undef PG8_SCHED
}
}
namespace attn2 {
constexpr int D = 128, DQ = 64, PU = 5120, PO = 1024;
constexpr float SCALE = 0.6931471805599453f;
constexpr float THR = 8.f;
constexpr bool WSKIP = false;
constexpr int NW = 8, QBLK = 32, KVBLK = 64, QB = NW * QBLK;
constexpr int SHM_V = KVBLK * D * 2, SHM_K = KVBLK * DQ * 2;
constexpr int LDS_BYTES = 2 * SHM_V + 2 * SHM_K + NW * 64 * 4;

using bf16 = __hip_bfloat16;
typedef short bf16x8 __attribute__((ext_vector_type(8)));
typedef short s16x4 __attribute__((ext_vector_type(4)));
typedef float f32x16 __attribute__((ext_vector_type(16)));
typedef float f32x4 __attribute__((ext_vector_type(4)));
typedef unsigned u32x4 __attribute__((ext_vector_type(4)));
template <class A, class Bt> struct same_t { static constexpr bool v = false; };
template <class A> struct same_t<A, A> { static constexpr bool v = true; };

#define KSWZ(row, colB) ((row) * 128 + ((colB) ^ (((row) & 7) << 4)))
#define SBAR() __builtin_amdgcn_sched_barrier(0)
__device__ __forceinline__ int v_st(int k, int c) { const int kk = (k & ~0xC) | ((k & 4) << 1) | ((k & 8) >> 1); return ((kk >> 3) * 4 + (c >> 5)) * 512 + ((kk & 7) * 32 + (c & 31)) * 2; }
__device__ __forceinline__ int v_rd_base(int lane) { return ((lane & 3) << 3) | (((lane >> 2) & 3) << 6) | (((lane >> 4) & 1) << 5) | (((lane >> 5) & 1) << 8); }
constexpr int v_rd_off(int d0, int ks, int half) { return d0 * 512 + ks * 4096 + half * 2048; }
__device__ __forceinline__ int crow(int r, int hi) { return (r & 3) + 8 * (r >> 2) + 4 * hi; }
__device__ __forceinline__ unsigned cvtpk(float lo, float hi) {
    unsigned r; asm volatile("v_cvt_pk_bf16_f32 %0, %1, %2" : "=v"(r) : "v"(lo), "v"(hi)); return r;
}
__device__ __forceinline__ bf16x8 pack8(f32x4 a, f32x4 b) {
    u32x4 w = {cvtpk(a[0], a[1]), cvtpk(a[2], a[3]), cvtpk(b[0], b[1]), cvtpk(b[2], b[3])};
    return *reinterpret_cast<bf16x8*>(&w);
}
template <class T> __device__ __forceinline__ bf16x8 load8(const T* p) {
    if constexpr (same_t<T, float>::v) { return pack8(*(const f32x4*)p, *(const f32x4*)(p + 4)); }
    else { return *reinterpret_cast<const bf16x8*>(p); }
}
__device__ __forceinline__ void mask_tile(f32x16& p0, f32x16& p1, int dq, unsigned W) {
    const float NEG = -__builtin_inff();
#pragma unroll
    for (int r = 0; r < 16; ++r) {
        const int c = (r & 3) + 8 * (r >> 2);
        if ((unsigned)(dq - c) >= W) p0[r] = NEG;
        if ((unsigned)(dq - c - 32) >= W) p1[r] = NEG;
    }
}
__device__ __forceinline__ void partialSM(f32x16& p0, f32x16& p1, float& m_reg, float& mn, float& alpha) {
    float pmax = p0[0]; for (int r = 1; r < 16; ++r) pmax = fmaxf(pmax, p0[r]); for (int r = 0; r < 16; ++r) pmax = fmaxf(pmax, p1[r]);
    { auto rr = __builtin_amdgcn_permlane32_swap(__float_as_uint(pmax), __float_as_uint(pmax), false, false);
      pmax = fmaxf(__uint_as_float(rr[0]), __uint_as_float(rr[1])); }
    constexpr float C2 = 1.4426950408889634f * SCALE;
    if (__builtin_expect(__all((pmax - m_reg) * SCALE <= THR), 1)) { mn = m_reg; alpha = 1.f; }
    else { mn = fmaxf(m_reg, pmax); alpha = __builtin_amdgcn_exp2f((m_reg - mn) * C2); m_reg = mn; }
    const float mnL = -mn * C2;
    { typedef float f32x2p __attribute__((ext_vector_type(2))); const f32x2p c2v = {C2, C2}, mv = {mnL, mnL};
#pragma unroll
      for (int r = 0; r < 16; r += 2) { f32x2p a = {p0[r], p0[r + 1]}, b = {p1[r], p1[r + 1]}; a = a * c2v + mv; b = b * c2v + mv; p0[r] = a.x; p0[r + 1] = a.y; p1[r] = b.x; p1[r + 1] = b.y; } }
    for (int r = 0; r < 16; ++r) p0[r] = __builtin_amdgcn_exp2f(p0[r]);
}
__device__ __forceinline__ void finishSM(f32x16& p0, f32x16& p1, float alpha, float& l_reg, bf16x8& pa0, bf16x8& pa1, bf16x8& pa2, bf16x8& pa3) {
    for (int r = 0; r < 16; ++r) p1[r] = __builtin_amdgcn_exp2f(p1[r]);
    float ps; { typedef float f32x2p __attribute__((ext_vector_type(2))); f32x2p s2 = {p0[0], p0[1]};
#pragma unroll
      for (int r = 2; r < 16; r += 2) s2 += (f32x2p){p0[r], p0[r + 1]};
#pragma unroll
      for (int r = 0; r < 16; r += 2) s2 += (f32x2p){p1[r], p1[r + 1]};
      ps = s2.x + s2.y; }
    { auto rr = __builtin_amdgcn_permlane32_swap(__float_as_uint(ps), __float_as_uint(ps), false, false);
      ps = __uint_as_float(rr[0]) + __uint_as_float(rr[1]); }
    l_reg = l_reg * alpha + ps;
#define PK4(P, B_, OUT) do { unsigned a0 = cvtpk(P[B_+0], P[B_+1]), a1 = cvtpk(P[B_+2], P[B_+3]);                          \
        unsigned b0 = cvtpk(P[B_+4], P[B_+5]), b1 = cvtpk(P[B_+6], P[B_+7]);                                             \
        auto r0 = __builtin_amdgcn_permlane32_swap(a0, b0, false, false); auto r1 = __builtin_amdgcn_permlane32_swap(a1, b1, false, false); \
        u32x4 w = {r0[0], r1[0], r0[1], r1[1]}; OUT = *reinterpret_cast<bf16x8*>(&w); } while (0)
    PK4(p0, 0, pa0); PK4(p0, 8, pa1); PK4(p1, 0, pa2); PK4(p1, 8, pa3);
#undef PK4
}
template <int KB, bool SK>
__device__ __forceinline__ void qkt(f32x16& p0, f32x16& p1, const char* K_lds, int r32, int hi, const bf16x8* qr, bool act) {
    if (SK && !act) { const float NEG = -__builtin_inff();
#pragma unroll
        for (int r = 0; r < 16; ++r) { p0[r] = NEG; p1[r] = NEG; } return; }
    p0 = f32x16{}; p1 = f32x16{};
    const char* kb[4];
#pragma unroll
    for (int dd = 0; dd < 4; ++dd) kb[dd] = K_lds + KB * SHM_K + KSWZ(r32, (dd * 16 + hi * 8) * 2);
#pragma unroll
    for (int d0 = 0; d0 < 4; ++d0) { const char* a = kb[d0];
        bf16x8 b0 = *reinterpret_cast<const bf16x8*>(a);
        bf16x8 b1 = *reinterpret_cast<const bf16x8*>(a + 32 * 128);
        p0 = __builtin_amdgcn_mfma_f32_32x32x16_bf16(b0, qr[d0], p0, 0, 0, 0);
        p1 = __builtin_amdgcn_mfma_f32_32x32x16_bf16(b1, qr[d0], p1, 0, 0, 0); }
}
template <int VB, bool SK>
__device__ __forceinline__ void pv_tile(f32x16* o, int vb0, bf16x8 pa0, bf16x8 pa1, bf16x8 pa2, bf16x8 pa3, bool act) {
    if (SK && !act) return;
#define TRRD(dst, off) asm volatile("ds_read_b64_tr_b16 %0, %1 offset:%2" : "=&v"(dst) : "v"(vb0), "i"(off) : "memory")
#define PV_D0(d0) do { s16x4 l0, l1, l2, l3, h0, h1, h2, h3; constexpr int b_ = VB * SHM_V + v_rd_off(d0, 0, 0);     \
        TRRD(l0, b_); TRRD(h0, b_ + 2048); TRRD(l1, b_ + 4096); TRRD(h1, b_ + 6144); TRRD(l2, b_ + 8192); TRRD(h2, b_ + 10240); TRRD(l3, b_ + 12288); TRRD(h3, b_ + 14336); \
        asm volatile("s_waitcnt lgkmcnt(0)" ::: "memory"); SBAR();                 \
        o[d0] = __builtin_amdgcn_mfma_f32_32x32x16_bf16(pa0, (bf16x8){l0[0], l0[1], l0[2], l0[3], h0[0], h0[1], h0[2], h0[3]}, o[d0], 0, 0, 0);   \
        o[d0] = __builtin_amdgcn_mfma_f32_32x32x16_bf16(pa1, (bf16x8){l1[0], l1[1], l1[2], l1[3], h1[0], h1[1], h1[2], h1[3]}, o[d0], 0, 0, 0);   \
        o[d0] = __builtin_amdgcn_mfma_f32_32x32x16_bf16(pa2, (bf16x8){l2[0], l2[1], l2[2], l2[3], h2[0], h2[1], h2[2], h2[3]}, o[d0], 0, 0, 0);   \
        o[d0] = __builtin_amdgcn_mfma_f32_32x32x16_bf16(pa3, (bf16x8){l3[0], l3[1], l3[2], l3[3], h3[0], h3[1], h3[2], h3[3]}, o[d0], 0, 0, 0); } while (0)
    PV_D0(0); PV_D0(1); PV_D0(2); PV_D0(3);
#undef PV_D0
#undef TRRD
}

template <int VB>
__device__ __forceinline__ void pv_sm(f32x16* o, int vb0, bf16x8 pa0, bf16x8 pa1, bf16x8 pa2, bf16x8 pa3, f32x16& p0, f32x16& p1, float& m_reg, float& mn, float& alpha) {
    typedef float f32x2p __attribute__((ext_vector_type(2)));
    constexpr float C2 = 1.4426950408889634f * SCALE;
    s16x4 l0, h0, l1, h1, l2, h2, l3, h3;
#define TRRD(dst, off) asm volatile("ds_read_b64_tr_b16 %0, %1 offset:%2" : "=&v"(dst) : "v"(vb0), "i"(off) : "memory")
#define LOADKS(ks) do { constexpr int b_ = VB * SHM_V + (ks) * 4096; TRRD(l0, b_); TRRD(h0, b_ + 2048); TRRD(l1, b_ + 512); TRRD(h1, b_ + 512 + 2048); \
        TRRD(l2, b_ + 1024); TRRD(h2, b_ + 1024 + 2048); TRRD(l3, b_ + 1536); TRRD(h3, b_ + 1536 + 2048); asm volatile("s_waitcnt lgkmcnt(0)" ::: "memory"); SBAR(); } while (0)
#define FRAG(l, h) (bf16x8){l[0], l[1], l[2], l[3], h[0], h[1], h[2], h[3]}
#define MMAKS(pa) do { o[0] = __builtin_amdgcn_mfma_f32_32x32x16_bf16(pa, FRAG(l0, h0), o[0], 0, 0, 0); o[1] = __builtin_amdgcn_mfma_f32_32x32x16_bf16(pa, FRAG(l1, h1), o[1], 0, 0, 0); \
        o[2] = __builtin_amdgcn_mfma_f32_32x32x16_bf16(pa, FRAG(l2, h2), o[2], 0, 0, 0); o[3] = __builtin_amdgcn_mfma_f32_32x32x16_bf16(pa, FRAG(l3, h3), o[3], 0, 0, 0); } while (0)
#define GRP4(nv) do { _Pragma("unroll") for (int g_ = 0; g_ < 4; ++g_) { __builtin_amdgcn_sched_group_barrier(0x008, 1, 0); __builtin_amdgcn_sched_group_barrier(0x002, nv, 0); } } while (0)
    LOADKS(0); MMAKS(pa0);
    float pmax = p0[0];
#pragma unroll
    for (int r = 1; r < 16; ++r) pmax = fmaxf(pmax, p0[r]);
#pragma unroll
    for (int r = 0; r < 16; ++r) pmax = fmaxf(pmax, p1[r]);
    GRP4(5); SBAR();
    LOADKS(1); MMAKS(pa1);
    { auto rr = __builtin_amdgcn_permlane32_swap(__float_as_uint(pmax), __float_as_uint(pmax), false, false);
      pmax = fmaxf(__uint_as_float(rr[0]), __uint_as_float(rr[1])); }
    const bool ok = __all((pmax - m_reg) * SCALE <= THR);
    const float mnew = fmaxf(m_reg, pmax);
    mn = ok ? m_reg : mnew; alpha = ok ? 1.f : __builtin_amdgcn_exp2f((m_reg - mnew) * C2); m_reg = mn;
    const f32x2p c2v = {C2, C2}, mv = {-mn * C2, -mn * C2};
#pragma unroll
    for (int r = 0; r < 16; r += 2) { f32x2p a = {p0[r], p0[r + 1]}; a = a * c2v + mv; p0[r] = a.x; p0[r + 1] = a.y; }
    GRP4(5); SBAR();
    LOADKS(2);
#define MM1(d, pa, l, h) o[d] = __builtin_amdgcn_mfma_f32_32x32x16_bf16(pa, FRAG(l, h), o[d], 0, 0, 0)
#define SH1(r) do { f32x2p b = {p1[r], p1[r + 1]}; b = b * c2v + mv; p1[r] = b.x; p1[r + 1] = b.y; } while (0)
#define EX1(r) p0[r] = __builtin_amdgcn_exp2f(p0[r])
    MM1(0, pa2, l0, h0); SH1(0); SH1(2); SH1(4); SH1(6);
    MM1(1, pa2, l1, h1); SH1(8); SH1(10); SH1(12); SH1(14);
    MM1(2, pa2, l2, h2); EX1(0); EX1(1); EX1(2); EX1(3);
    MM1(3, pa2, l3, h3); EX1(4); EX1(5); EX1(6); EX1(7);
    asm volatile("" : "+v"(p0), "+v"(p1));
    { __builtin_amdgcn_sched_group_barrier(0x008, 1, 0); __builtin_amdgcn_sched_group_barrier(0x402, 4, 0); __builtin_amdgcn_sched_group_barrier(0x008, 1, 0); __builtin_amdgcn_sched_group_barrier(0x402, 4, 0);
      __builtin_amdgcn_sched_group_barrier(0x008, 1, 0); __builtin_amdgcn_sched_group_barrier(0x402, 4, 0); __builtin_amdgcn_sched_group_barrier(0x008, 1, 0); __builtin_amdgcn_sched_group_barrier(0x402, 4, 0); }
    SBAR();
    LOADKS(3);
    MM1(0, pa3, l0, h0); EX1(8); EX1(9);
    MM1(1, pa3, l1, h1); EX1(10); EX1(11);
    MM1(2, pa3, l2, h2); EX1(12); EX1(13);
    MM1(3, pa3, l3, h3); EX1(14); EX1(15);
    asm volatile("" : "+v"(p0));
    { __builtin_amdgcn_sched_group_barrier(0x008, 1, 0); __builtin_amdgcn_sched_group_barrier(0x402, 2, 0); __builtin_amdgcn_sched_group_barrier(0x008, 1, 0); __builtin_amdgcn_sched_group_barrier(0x402, 2, 0);
      __builtin_amdgcn_sched_group_barrier(0x008, 1, 0); __builtin_amdgcn_sched_group_barrier(0x402, 2, 0); __builtin_amdgcn_sched_group_barrier(0x008, 1, 0); __builtin_amdgcn_sched_group_barrier(0x402, 2, 0); }
    SBAR();
#undef MM1
#undef SH1
#undef EX1
#undef TRRD
#undef LOADKS
#undef FRAG
#undef MMAKS
#undef GRP4
}
template <class TIn, class TOut> struct BlockRef { const TIn* Q; const TIn* K; const TIn* V; TOut* O; int P0; };
template <class TIn> struct Seam {
    bf16x8 qr[4];
    bf16x8 st_v0, st_v1, st_k0;
};
__device__ __forceinline__ int swa_jlo(int P0, int W) { const int lowk = P0 - W + 1; return lowk > 0 ? lowk / KVBLK : 0; }
#define ROW(p, k0, rr) ((p) + (size_t)((k0) + (rr)) * PU + sc)
#define ROWK(p, k0) ((p) + (size_t)((k0) + skr) * PU + skc)
#define VMW() asm volatile("s_waitcnt vmcnt(0)" ::: "memory")
#define VMWN(n) asm volatile("s_waitcnt vmcnt(%0)" :: "i"(n) : "memory")
#define SLOAD_H(Kp, Vp, k0) do { S.st_v0 = load8<TIn>(ROW(Vp, k0, sr)); S.st_v1 = load8<TIn>(ROW(Vp, k0, 32 + sr));              \
                         S.st_k0 = load8<TIn>(ROWK(Kp, k0)); } while (0)
#define SWRITE_HK(bf) do { *(bf16x8*)(K_lds + (bf) * SHM_K + kws) = S.st_k0; } while (0)
#define SWRITE_HV(bf) do { *(bf16x8*)(V_lds + (bf) * SHM_V + vst0) = S.st_v0; *(bf16x8*)(V_lds + (bf) * SHM_V + vst1) = S.st_v1; } while (0)
#define SWRITE_H(bf) do { SWRITE_HV(bf); SWRITE_HK(bf); } while (0)
#define SLOAD_F(p, k0) do { S.sf0 = *(const f32x4*)ROW(p, k0, sr); S.sf1 = *(const f32x4*)(ROW(p, k0, sr) + 4);                \
                            S.sf2 = *(const f32x4*)ROW(p, k0, 32 + sr); S.sf3 = *(const f32x4*)(ROW(p, k0, 32 + sr) + 4); } while (0)
#define SWRITE_KF(bf) do { *(bf16x8*)(K_lds + (bf) * SHM_K + kws) = pack8(S.sf0, S.sf1); *(bf16x8*)(K_lds + (bf) * SHM_K + kws + 32 * 256) = pack8(S.sf2, S.sf3); } while (0)
#define SWRITE_VF(bf) do { *(bf16x8*)(V_lds + (bf) * SHM_V + vst0) = pack8(S.sf0, S.sf1); *(bf16x8*)(V_lds + (bf) * SHM_V + vst1) = pack8(S.sf2, S.sf3); } while (0)
template <class TIn, class TOut>
__device__ __forceinline__ void causal_swa_prime(const BlockRef<TIn, TOut>& cur, int W, char* lds, Seam<TIn>& S) {
    constexpr bool F32 = same_t<TIn, float>::v;
    const int tid = otid(), wid = __builtin_amdgcn_readfirstlane(tid >> 6), lane = tid & 63, r32 = lane & 31, hi = lane >> 5;
    const int sr = tid >> 4, sc = (tid & 15) * 8, skr = tid >> 3, skc = (tid & 7) * 8, kws = KSWZ(skr, skc * 2); char* K_lds = lds + 2 * SHM_V;
    const int kb0 = swa_jlo(cur.P0, W) * KVBLK;
    for (int d0 = 0; d0 < 4; ++d0) S.qr[d0] = load8<TIn>(cur.Q + (size_t)(wid * QBLK + r32) * PU + d0 * 16 + hi * 8);
    if constexpr (F32) { SLOAD_F((const float*)cur.K, kb0); VMW(); SWRITE_KF(0); SBAR(); SLOAD_F((const float*)cur.V, kb0); }
    else { SLOAD_H(cur.K, cur.V, kb0); VMW(); SWRITE_HK(0); }
    __syncthreads();
}
template <class TIn, class TOut>
__device__ __forceinline__ void causal_swa_block(const BlockRef<TIn, TOut>& cur, const BlockRef<TIn, TOut>& nxt, int skv, int W, char* lds, Seam<TIn>& S) {
    constexpr bool F32 = same_t<TIn, float>::v;
    const int tid = otid(), wid = __builtin_amdgcn_readfirstlane(tid >> 6), lane = tid & 63, r32 = lane & 31, hi = lane >> 5;
    const int j_lo = swa_jlo(cur.P0, W);
    int j_hi = (cur.P0 + QB - 1) / KVBLK + 1; if (j_hi > skv / KVBLK) j_hi = skv / KVBLK;
    const int NT = j_hi - j_lo;
    const int kbn = swa_jlo(nxt.P0, W) * KVBLK;
    const int qeff = (cur.P0 + wid * QBLK) | 63;
    char* V_lds = lds; char* K_lds = lds + 2 * SHM_V;
    float* ws = (float*)(lds + 2 * SHM_V + 2 * SHM_K) + wid * 64; float* li_l = ws, * al_l = ws + 32;
    float m_reg = -1e30f, l_reg = 0; f32x16 o[4] = {};
    const int sr = tid >> 4, sc = (tid & 15) * 8, vst0 = v_st(sr, sc), vst1 = v_st(32 + sr, sc), skr = tid >> 3, skc = (tid & 7) * 8, kws = KSWZ(skr, skc * 2);
    const int vb0 = (int)(uintptr_t)V_lds + v_rd_base(lane);
    const TIn* Kh = cur.K; const TIn* Vh = cur.V;
#define RESC(a) do { if (__any((a) < 1.f)) { if (hi == 0) al_l[r32] = (a); asm volatile("s_waitcnt lgkmcnt(0)" ::: "memory");              \
                     for (int d_ = 0; d_ < 4; ++d_) for (int r = 0; r < 16; ++r) o[d_][r] *= al_l[crow(r, hi)]; } } while (0)
#define KBASE(t) ((j_lo + (t)) * KVBLK)
#define ACT(t) (KBASE(t) <= qeff)
#define MASKT(P0_, P1_, t) do { if (__builtin_expect(!ACT(t), 0)) { asm volatile("" ::: "memory");     \
        const float NEG_ = -__builtin_inff(); _Pragma("unroll") for (int r_ = 0; r_ < 16; ++r_) { P0_[r_] = NEG_; P1_[r_] = NEG_; } } } while (0)
    constexpr int NQL = F32 ? 16 : 4;
    constexpr bool SK = WSKIP && !F32;
#define SEAM_K0() do { VMWN(NQL); if constexpr (F32) { SWRITE_KF(0); SBAR(); SLOAD_F((const float*)nxt.V, kbn); } else { SWRITE_HK(0); } SBAR(); } while (0)
    f32x16 pA0, pA1, pB0, pB1; float mnA, mnB, alA, alB; bf16x8 pa0, pa1, pa2, pa3;
    if constexpr (F32) { VMW(); SWRITE_VF(0); SBAR(); } else { SWRITE_HV(0); SBAR(); }
    if (NT > 1) { if constexpr (F32) SLOAD_F((const float*)Kh, KBASE(1)); else SLOAD_H(Kh, Vh, KBASE(1)); }
    SBAR(); qkt<0, SK>(pA0, pA1, K_lds, r32, hi, S.qr, ACT(0));
    if constexpr (F32) { if (NT > 1) { VMW(); SWRITE_KF(1); SBAR(); SLOAD_F((const float*)Vh, KBASE(1)); } }
    MASKT(pA0, pA1, 0); partialSM(pA0, pA1, m_reg, mnA, alA);
    if (NT > 1) { VMW(); if constexpr (F32) { SWRITE_VF(1); SBAR(); if (NT > 2) SLOAD_F((const float*)Kh, KBASE(2)); } else SWRITE_H(1); }
    __syncthreads();
#define HALF_STEP(PX0, PX1, mnX, alX, PY0, PY1, alY, t, KB, VB, SB) do {                                                      \
        SBAR(); qkt<KB, SK>(PX0, PX1, K_lds, r32, hi, S.qr, ACT(t));                                             \
        finishSM(PY0, PY1, alY, l_reg, pa0, pa1, pa2, pa3); SBAR();                                                           \
        if ((t) + 1 < NT) { if constexpr (F32) { VMW(); SWRITE_KF(SB); SBAR(); SLOAD_F((const float*)Vh, KBASE((t) + 1)); }  \
                            else { SLOAD_H(Kh, Vh, KBASE((t) + 1)); } SBAR(); }                                               \
        MASKT(PX0, PX1, (t)); pv_sm<VB>(o, vb0, pa0, pa1, pa2, pa3, PX0, PX1, m_reg, mnX, alX);                                                                          \
        __syncthreads();                                                                                                      \
        if ((t) + 1 < NT) { VMW(); if constexpr (F32) { SWRITE_VF(SB); SBAR(); if ((t) + 2 < NT) SLOAD_F((const float*)Kh, KBASE((t) + 2)); } \
                            else { SWRITE_H(SB); } }                                                                          \
        RESC(alX); __syncthreads(); } while (0)
    for (int t = 1; t + 1 < NT; t += 2) {
        HALF_STEP(pB0, pB1, mnB, alB, pA0, pA1, alA, t, 1, 0, 0);
        HALF_STEP(pA0, pA1, mnA, alA, pB0, pB1, alB, t + 1, 0, 1, 1);
    }
    const bool even = (NT & 1) == 0;
    if (even) { SBAR(); qkt<1, SK>(pB0, pB1, K_lds, r32, hi, S.qr, ACT(NT - 1)); SBAR(); }
#define QROW(e) (nxt.Q + (size_t)(wid * QBLK + r32) * D + ((e) >> 1) * 16 + hi * 8 + ((e) & 1) * 4)
    if constexpr (F32) { SLOAD_F((const float*)nxt.K, kbn); SBAR();
#pragma unroll
        for (int e = 0; e < 8; ++e) S.tq[e] = *(const f32x4*)QROW(e); }
    else { SLOAD_H(nxt.K, nxt.V, kbn); SBAR();
#pragma unroll
        for (int d0 = 0; d0 < 4; ++d0) S.qr[d0] = load8<TIn>(nxt.Q + (size_t)(wid * QBLK + r32) * PU + d0 * 16 + hi * 8); }
    SBAR();
    finishSM(pA0, pA1, alA, l_reg, pa0, pa1, pa2, pa3); SBAR();
    if constexpr (F32) {
#pragma unroll
        for (int e = 8; e < 16; ++e) S.tq[e] = *(const f32x4*)QROW(e); SBAR(); }
#undef QROW
    pv_tile<0, SK>(o, vb0, pa0, pa1, pa2, pa3, ACT(even ? NT - 2 : NT - 1));
    if (even) { MASKT(pB0, pB1, NT - 1); partialSM(pB0, pB1, m_reg, mnB, alB); __syncthreads(); RESC(alB);
        finishSM(pB0, pB1, alB, l_reg, pa0, pa1, pa2, pa3); SBAR(); pv_tile<1, SK>(o, vb0, pa0, pa1, pa2, pa3, ACT(NT - 1)); }
    SBAR(); SEAM_K0();
    if (hi == 0) li_l[r32] = l_reg; asm volatile("s_waitcnt lgkmcnt(0)" ::: "memory");
    float rli[16];
#pragma unroll
    for (int r = 0; r < 16; ++r) rli[r] = __builtin_amdgcn_rcpf(li_l[crow(r, hi)]);
    TOut* Ow = cur.O + (size_t)(wid * QBLK) * PO;
#pragma unroll
    for (int r = 0; r < 16; ++r) { const int orow = crow(r, hi);
#pragma unroll
        for (int d0 = 0; d0 < 4; ++d0) { const float v = o[d0][r] * rli[r];
            if constexpr (same_t<TOut, float>::v) { Ow[(size_t)orow * PO + d0 * 32 + r32] = v; }
            else { const float vn = __shfl_xor(v, 1);
                   if ((r32 & 1) == 0) *(unsigned*)(Ow + (size_t)orow * PO + d0 * 32 + r32) = cvtpk(v, vn); } } }
    if constexpr (F32) {
#pragma unroll
        for (int d0 = 0; d0 < 8; ++d0) S.qr[d0] = pack8(S.tq[2 * d0], S.tq[2 * d0 + 1]); }
    __syncthreads();
#undef RESC
#undef KBASE
#undef ACT
#undef MASKT
#undef SEAM_K0
#undef HALF_STEP
}
#undef ROW
#undef VMW
#undef VMWN
#undef SLOAD_H
#undef SWRITE_HK
#undef SWRITE_HV
#undef SWRITE_H
#undef SLOAD_F
#undef SWRITE_KF
#undef SWRITE_VF

}
namespace cg = cooperative_groups;
#define LAS __attribute__((address_space(3)))
typedef unsigned short bf16;
typedef unsigned v4u __attribute__((ext_vector_type(4)));
typedef unsigned v2u __attribute__((ext_vector_type(2)));
typedef float f32x4 __attribute__((ext_vector_type(4)));

constexpr int NWAVES = 8, NTHR = 512;
constexpr int BATCH = 4, SEQ = 8192, DMODEL = 1024, M = BATCH * SEQ;
constexpr int NU = 5120, NY = 1536, INC = 5128;
constexpr int U_AQ = 0, U_AK = 512, U_AV = 1024, U_AZ = 1536, U_GQ = 2048, U_GK = 2560, U_GV = 3072, U_GZ = 3584, U_RX = 4096, U_RZ = 4608;
constexpr size_t MiB = 1u << 20;
constexpr size_t WS_CTL = 0, WS_WIN = 2 * MiB, WS_WOUT = 22 * MiB, WS_WG = 28 * MiB, WS_GBA = 30 * MiB, WS_XN = 32 * MiB, WS_U = 96 * MiB, WS_Y = 416 * MiB, WS_END = 512 * MiB;
constexpr int RING_BYTES = 131072, MISC_OFF = RING_BYTES + 320, LDS_BYTES = 147456;
constexpr float ATT_C2 = 0.125f * 1.4426950408889634f;
constexpr int N_GDN_UNITS = 16, N_LRU_UNITS = 128, N_ATT_UNITS = 1024;

__device__ __forceinline__ unsigned f2bf(float f) { unsigned u = __builtin_bit_cast(unsigned, f); return (u + 0x7fffu + ((u >> 16) & 1u)) >> 16; }
__device__ __forceinline__ unsigned pk2(float lo, float hi) { return f2bf(lo) | (f2bf(hi) << 16); }
__device__ __forceinline__ float bflo(unsigned w) { return __builtin_bit_cast(float, w << 16); }
__device__ __forceinline__ float bfhi(unsigned w) { return __builtin_bit_cast(float, w & 0xffff0000u); }
__device__ __forceinline__ float bf1(bf16 v) { return __builtin_bit_cast(float, (unsigned)v << 16); }
__device__ __forceinline__ float fexp(float x) { return __builtin_amdgcn_exp2f(x * 1.4426950408889634f); }
__device__ __forceinline__ float flog(float x) { return __builtin_amdgcn_logf(x) * 0.6931471805599453f; }
__device__ __forceinline__ float sigmoidf_(float x) { return __builtin_amdgcn_rcpf(1.0f + fexp(-x)); }
__device__ __forceinline__ float softplusf_(float x) {
    if (x > 20.f) return x;
    const float y = fexp(x);
    return y < 0.01f ? y * (1.f - y * (0.5f - y * 0.33333334f)) : flog(1.f + y);
}
__device__ __forceinline__ float wave_sum(float v) {
#pragma unroll
    for (int o = 1; o < 64; o <<= 1) v += __shfl_xor(v, o);
    return v;
}
template <int CTRL> __device__ __forceinline__ float dpp_f(float x) {
    return __builtin_bit_cast(float, __builtin_amdgcn_update_dpp(0, __builtin_bit_cast(int, x), CTRL, 0xF, 0xF, false));
}
__device__ __forceinline__ float row16_sum(float x) {
    x += dpp_f<0x128>(x); x += dpp_f<0x124>(x); x += dpp_f<0x122>(x); x += dpp_f<0x121>(x); return x;
}

struct Args { const float* in[16]; float* out; unsigned char* ws; };

typedef const __attribute__((address_space(4))) Args* KArgP;
__device__ __forceinline__ KArgP kargs() { KArgP p = (KArgP)__builtin_amdgcn_kernarg_segment_ptr(); asm volatile("" : "+s"(p)); return p; }
struct TI { int tid, lane, wave, G; };
__device__ __forceinline__ TI ti() { TI t; t.tid = otid(); t.lane = t.tid & 63; t.wave = __builtin_amdgcn_readfirstlane(t.tid >> 6); t.G = ogrid(); return t; }

namespace pg8 {
struct EpiRes {
    static constexpr bool PERM = false, AFTER_DRAIN = false;
    const float* base; float* out; int ldc;
    __device__ __forceinline__ void operator()(const f32x4 (&acc)[2][2][4][2], const Unit& u, int wr, int wc, int fr, int fq) const {
        const int col0 = u.pn * BM + wc * 32 + 4 * fq;
#pragma unroll
        for (int ai = 0; ai < 2; ++ai)
#pragma unroll
            for (int m = 0; m < 4; ++m) { const size_t off = (size_t)(u.pm * BM + ai * HALF + wr * 64 + m * 16 + fr) * ldc + col0;
#pragma unroll
                for (int bj = 0; bj < 2; ++bj)
#pragma unroll
                    for (int n = 0; n < 2; ++n) { const f32x4 bs = *(const f32x4*)(base + off + bj * HALF + n * 16); *(f32x4*)(out + off + bj * HALF + n * 16) = bs + acc[ai][bj][m][n]; } }
    }
};
struct EpiGate {
    static constexpr bool PERM = true, AFTER_DRAIN = false;
    bf16_t* O0; int ldc0; bf16_t* O1; int ldc1; const float* bias;
    __device__ __forceinline__ void operator()(const f32x4 (&acc)[2][2][4][2], const Unit& u, int wr, int wc, int fr, int fq) const {
        const int row0 = u.pm * BM + wr * 64 + fr; int colt = u.pn * BM; const int t = colt / 512; bf16_t* base = t ? O1 : O0; const int ldc = t ? ldc1 : ldc0; colt -= t * 512;
        const int col0 = colt + wc * 32 + 8 * fq, bcol0 = u.pn * BM + wc * 32 + 8 * fq;
        f32x4 bv[2][2];
#pragma unroll
        for (int bj = 0; bj < 2; ++bj)
#pragma unroll
            for (int n = 0; n < 2; ++n) bv[bj][n] = *(const f32x4*)(bias + bcol0 + bj * HALF + 4 * n);
#pragma unroll
        for (int ai = 0; ai < 2; ++ai)
#pragma unroll
            for (int m = 0; m < 4; ++m) { bf16_t* rowp = base + (size_t)(row0 + ai * HALF + m * 16) * ldc + col0;
#pragma unroll
                for (int bj = 0; bj < 2; ++bj) { const f32x4 v0 = acc[ai][bj][m][0] + bv[bj][0], v1 = acc[ai][bj][m][1] + bv[bj][1];
                    u32x4 w; w.x = cvt_pk_bf16(v0[0], v0[1]); w.y = cvt_pk_bf16(v0[2], v0[3]); w.z = cvt_pk_bf16(v1[0], v1[1]); w.w = cvt_pk_bf16(v1[2], v1[3]);
                    *(u32x4*)(rowp + bj * HALF) = w; } }
    }
};
}

__device__ __forceinline__ void transpose_item(const float* W, int pitch, int K, bf16* WT, LAS float* scr, int kb, int nb, int lane) {
    const int k0 = 64 * kb, n0 = 32 * nb;
#pragma unroll 8
    for (int i = 0; i < 32; ++i) { const int kk = 2 * i + (lane >> 5); scr[kk * 33 + (lane & 31)] = W[(size_t)(k0 + kk) * pitch + n0 + (lane & 31)]; }
    asm volatile("s_waitcnt lgkmcnt(0)" ::: "memory");
    const int c = lane & 7;
#pragma unroll
    for (int j = 0; j < 4; ++j) { const int n = (lane >> 3) + 8 * j; const LAS float* s = scr + (8 * c) * 33 + n;
        v4u o; o.x = pk2(s[0 * 33], s[1 * 33]); o.y = pk2(s[2 * 33], s[3 * 33]); o.z = pk2(s[4 * 33], s[5 * 33]); o.w = pk2(s[6 * 33], s[7 * 33]);
        *(v4u*)(WT + (size_t)(n0 + n) * K + k0 + 8 * c) = o; }
    asm volatile("s_waitcnt lgkmcnt(0)" ::: "memory");
}
__device__ __forceinline__ void p0_weights(LAS unsigned char* lds, const float* w_in, const float* w_out, const float* lru_gate_w, bf16* Wt_in, bf16* Wt_out, bf16* Wt_g) {
    const TI F = ti();
    LAS float* scr = (LAS float*)(lds + F.wave * 16384);
    const int gw = obid() * NWAVES + F.wave, NGW = F.G * NWAVES;
    constexpr int I_A = 16 * 128, I_B = 16 * 32, I_O = 24 * 32, PER_L = I_A + I_B + I_O;
    for (int it = gw; it < 2 * PER_L; it += NGW) {
        const int l = it / PER_L; int r = it % PER_L;
        const float* win = w_in + (size_t)l * DMODEL * INC; bf16* wt = Wt_in + (size_t)l * NU * DMODEL;
        if (r < I_A) { transpose_item(win, INC, DMODEL, wt, scr, r / 128, r % 128, F.lane); continue; } r -= I_A;
        if (r < I_B) { transpose_item(win + 4104, INC, DMODEL, wt + (size_t)4096 * DMODEL, scr, r / 32, r % 32, F.lane); continue; } r -= I_B;
        transpose_item(w_out + (size_t)l * NY * DMODEL, DMODEL, NY, Wt_out + (size_t)l * DMODEL * NY, scr, r / 32, r % 32, F.lane);
    }
    for (int idx = obid() * NTHR + F.tid; idx < 2 * 1024 * 256; idx += F.G * NTHR) {
        const int l = idx >> 18, rem = idx & 262143, n = rem >> 8, k = (rem & 255) * 2;
        const int g = n >> 9, nb = (n >> 7) & 3, e = n & 127, kb = k >> 7, d = k & 127;
        unsigned w = 0u;
        if (kb == nb) { const float* gw_ = lru_gate_w + ((((size_t)(l * 2 + g) * 4 + nb) * 128 + d) * 128 + e); w = pk2(gw_[0], gw_[128]); }
        *(unsigned*)(Wt_g + (size_t)l * 1024 * 512 + (size_t)n * 512 + k) = w;
    }
}

__device__ __forceinline__ void norm_phase(LAS unsigned char* lds, const float* xsrc, const float* win, const float* nw, bf16* XN, float* GBA) {
    const TI F = ti();
    LAS float* wg = (LAS float*)lds;
    for (int idx = F.tid; idx < 8192; idx += NTHR) { const int k = idx >> 3, j = idx & 7; wg[j * 1024 + k] = win[(size_t)k * INC + 4096 + j]; }
    __syncthreads();
    f32x4 wv[4];
#pragma unroll
    for (int j = 0; j < 4; ++j) wv[j] = *(const f32x4*)(nw + 4 * F.lane + 256 * j);
    const int gw = obid() * NWAVES + F.wave, NGW = F.G * NWAVES;
    const int lane = F.lane; const bool b32 = (lane & 32) != 0, b16 = (lane & 16) != 0, b8 = (lane & 8) != 0;
    for (int row0 = gw * 2; row0 < M; row0 += NGW * 2) {
        f32x4 v[2][4]; float s[2];
#pragma unroll
        for (int rr = 0; rr < 2; ++rr) { const f32x4* xr = (const f32x4*)(xsrc + (size_t)(row0 + rr) * DMODEL) + lane; s[rr] = 0.f;
#pragma unroll
            for (int j = 0; j < 4; ++j) { v[rr][j] = xr[64 * j]; s[rr] += (v[rr][j].x * v[rr][j].x + v[rr][j].y * v[rr][j].y) + (v[rr][j].z * v[rr][j].z + v[rr][j].w * v[rr][j].w); } }
#pragma unroll
        for (int rr = 0; rr < 2; ++rr) { const int row = row0 + rr;
            const float r = rsqrtf(wave_sum(s[rr]) * (1.0f / DMODEL) + 1e-6f);
            unsigned long long* o8 = (unsigned long long*)(XN + (size_t)row * DMODEL) + lane;
            float acc[8];
#pragma unroll
            for (int jj = 0; jj < 8; ++jj) acc[jj] = 0.f;
#pragma unroll
            for (int j = 0; j < 4; ++j) {
                const f32x4 hv = v[rr][j] * r * wv[j];
                o8[64 * j] = (unsigned long long)pk2(hv.x, hv.y) | ((unsigned long long)pk2(hv.z, hv.w) << 32);
#pragma unroll
                for (int jj = 0; jj < 8; ++jj) { const f32x4 w4 = *(const LAS f32x4*)(wg + jj * 1024 + 4 * lane + 256 * j);
                    acc[jj] += (hv.x * w4.x + hv.y * w4.y) + (hv.z * w4.z + hv.w * w4.w); }
            }
            float t4[4], u2[2];
#pragma unroll
            for (int k = 0; k < 4; ++k) { const float send = b32 ? acc[k] : acc[k + 4], keep = b32 ? acc[k + 4] : acc[k]; t4[k] = keep + __shfl_xor(send, 32); }
#pragma unroll
            for (int k = 0; k < 2; ++k) { const float send = b16 ? t4[k] : t4[k + 2], keep = b16 ? t4[k + 2] : t4[k]; u2[k] = keep + __shfl_xor(send, 16); }
            float w1; { const float send = b8 ? u2[0] : u2[1], keep = b8 ? u2[1] : u2[0]; w1 = keep + __shfl_xor(send, 8); }
            w1 += __shfl_xor(w1, 4); w1 += __shfl_xor(w1, 2); w1 += __shfl_xor(w1, 1);
            if ((lane & 7) == 0) GBA[(size_t)row * 8 + (lane >> 3)] = w1;
        }
    }
    __syncthreads();
}
__device__ __forceinline__ void final_norm_phase(float* out, const float* fnw) {
    const TI F = ti();
    f32x4 wv[4];
#pragma unroll
    for (int j = 0; j < 4; ++j) wv[j] = *(const f32x4*)(fnw + 4 * F.lane + 256 * j);
    const int gw = obid() * NWAVES + F.wave, NGW = F.G * NWAVES;
    for (int row0 = gw * 2; row0 < M; row0 += NGW * 2) {
        f32x4 v[2][4]; float s[2];
#pragma unroll
        for (int rr = 0; rr < 2; ++rr) { const f32x4* xr = (const f32x4*)(out + (size_t)(row0 + rr) * DMODEL) + F.lane; s[rr] = 0.f;
#pragma unroll
            for (int j = 0; j < 4; ++j) { v[rr][j] = xr[64 * j]; s[rr] += (v[rr][j].x * v[rr][j].x + v[rr][j].y * v[rr][j].y) + (v[rr][j].z * v[rr][j].z + v[rr][j].w * v[rr][j].w); } }
#pragma unroll
        for (int rr = 0; rr < 2; ++rr) { const int row = row0 + rr; f32x4* xr = (f32x4*)(out + (size_t)row * DMODEL) + F.lane;
            const float r = rsqrtf(wave_sum(s[rr]) * (1.0f / DMODEL) + 1e-6f);
#pragma unroll
            for (int j = 0; j < 4; ++j) xr[64 * j] = v[rr][j] * r * wv[j]; }
    }
}

__device__ __forceinline__ void unpack8(const v4u w, float (&f)[8]) {
    f[0] = bflo(w.x); f[1] = bfhi(w.x); f[2] = bflo(w.y); f[3] = bfhi(w.y); f[4] = bflo(w.z); f[5] = bfhi(w.z); f[6] = bflo(w.w); f[7] = bfhi(w.w);
}
__device__ __forceinline__ v4u pack8(const float* y) { v4u o; o.x = pk2(y[0], y[1]); o.y = pk2(y[2], y[3]); o.z = pk2(y[4], y[5]); o.w = pk2(y[6], y[7]); return o; }
__device__ __forceinline__ void lru_conv_phase(const float* cwl, const float* cbl, const bf16* U, bf16* Y) {
    const TI F = ti();
    const int cgp = F.tid & 63, ts = F.tid >> 6, c0 = cgp * 8;
    float w[4][8], bb[8];
#pragma unroll
    for (int j = 0; j < 4; ++j) { const f32x4 a = *(const f32x4*)(cwl + (size_t)j * 512 + c0), b = *(const f32x4*)(cwl + (size_t)j * 512 + c0 + 4);
        w[j][0] = a.x; w[j][1] = a.y; w[j][2] = a.z; w[j][3] = a.w; w[j][4] = b.x; w[j][5] = b.y; w[j][6] = b.z; w[j][7] = b.w; }
    { const f32x4 a = *(const f32x4*)(cbl + c0), b = *(const f32x4*)(cbl + c0 + 4);
      bb[0] = a.x; bb[1] = a.y; bb[2] = a.z; bb[3] = a.w; bb[4] = b.x; bb[5] = b.y; bb[6] = b.z; bb[7] = b.w; }
    for (int tile = obid(); tile < M / 64; tile += F.G) {
        const int row0 = tile * 64 + ts * 8, tin = row0 & (SEQ - 1);
        float p1[8], p2[8], p3[8], cur[8];
        const bf16* src = U + (size_t)row0 * NU + U_RX + c0;
        if (tin == 0) {
#pragma unroll
            for (int c = 0; c < 8; ++c) { p1[c] = 0.f; p2[c] = 0.f; p3[c] = 0.f; }
        } else {
            unpack8(*(const v4u*)(src - 1 * (ptrdiff_t)NU), p1); unpack8(*(const v4u*)(src - 2 * (ptrdiff_t)NU), p2); unpack8(*(const v4u*)(src - 3 * (ptrdiff_t)NU), p3);
        }
#pragma unroll
        for (int i = 0; i < 8; ++i) {
            unpack8(*(const v4u*)(src + (size_t)i * NU), cur);
            float y[8];
#pragma unroll
            for (int c = 0; c < 8; ++c) y[c] = bb[c] + w[0][c] * p3[c] + w[1][c] * p2[c] + w[2][c] * p1[c] + w[3][c] * cur[c];
            v4u o; o.x = pk2(y[0], y[1]); o.y = pk2(y[2], y[3]); o.z = pk2(y[4], y[5]); o.w = pk2(y[6], y[7]);
            *(v4u*)(Y + (size_t)(row0 + i) * NY + 1024 + c0) = o;
#pragma unroll
            for (int c = 0; c < 8; ++c) { p3[c] = p2[c]; p2[c] = p1[c]; p1[c] = cur[c]; }
        }
    }
}

__device__ __forceinline__ void lru_unit(LAS unsigned char* lds, int w, const float* lpl, const bf16* U, bf16* Y) {
    const TI F = ti();
    const int b = w >> 5, c0 = (w & 31) * 16, seg = F.tid >> 4, c = F.tid & 15, ch = c0 + c;
    LAS float* segP = (LAS float*)lds; LAS float* segH = segP + 512;
    const float lp = lpl[ch];
    const float sp = softplusf_(-lp);
    const float c8 = -8.0f * sp;
    const size_t rowb = (size_t)b * SEQ + (size_t)seg * 256;
    const bf16* pxc = Y + rowb * NY + 1024 + ch; const bf16* pg0 = U + rowb * NU + U_RX + ch; const bf16* pg1 = Y + rowb * NY + ch; const bf16* pz = U + rowb * NU + U_RZ + ch;
    float h = 0.f, P = 1.f;
#pragma unroll 4
    for (int t = 0; t < 256; ++t) {
        const float xc = bf1(pxc[(size_t)t * NY]), g0 = bf1(pg0[(size_t)t * NU]), g1 = bf1(pg1[(size_t)t * NY]);
        const float it = sigmoidf_(g0), rt = sigmoidf_(g1), la = c8 * rt, a = fexp(la);
        const float bt = sqrtf(fmaxf(1.0f - a * a, 0.f)) * (it * xc);
        h = a * h + bt; P *= a;
    }
    segP[seg * 16 + c] = P; segH[seg * 16 + c] = h;
    __syncthreads();
    float hin = 0.f;
    for (int s = 0; s < seg; ++s) hin = segP[s * 16 + c] * hin + segH[s * 16 + c];
    h = hin;
    bf16* py = Y + rowb * NY + 1024 + ch;
#pragma unroll 4
    for (int t = 0; t < 256; ++t) {
        const float xc = bf1(pxc[(size_t)t * NY]), g0 = bf1(pg0[(size_t)t * NU]), g1 = bf1(pg1[(size_t)t * NY]), z = bf1(pz[(size_t)t * NU]);
        const float it = sigmoidf_(g0), rt = sigmoidf_(g1), la = c8 * rt, a = fexp(la);
        const float bt = sqrtf(fmaxf(1.0f - a * a, 0.f)) * (it * xc);
        h = a * h + bt;
        py[(size_t)t * NY] = (bf16)f2bf(h * z * sigmoidf_(z));
    }
    __syncthreads();
}

__device__ __forceinline__ void gdn_halo_load(LAS unsigned char* L, const bf16* U) {
    const TI F = ti(); const int bid = obid();
    for (int slot = 0; slot < 2; ++slot) { const int tile = bid + slot * F.G; if (tile >= M / 64) break; const size_t t0 = (size_t)tile * 64;
        for (int idx = F.tid; idx < 576; idx += NTHR) { const int row = idx / 192, g = idx % 192; unsigned z = 0u; asm volatile("" : "+v"(z)); v4u v = (v4u){z, z, z, z};
            if ((t0 & (SEQ - 1)) != 0) v = *(const v4u*)(U + (t0 - 3 + row) * NU + U_GQ + g * 8);
            *(LAS v4u*)(L + slot * 9216 + row * 3072 + g * 16) = v; } }
}
__device__ __forceinline__ void gdn_conv_inplace(LAS unsigned char* L, bf16* U, const float* cwl) {
    const TI F = ti(); const int bid = obid();
    if (F.tid >= 384) return;
    const int slot = F.tid / 192, g = F.tid % 192, tile = bid + slot * F.G;
    if (tile >= M / 64) return;
    float cw[4][8];
#pragma unroll
    for (int j = 0; j < 4; ++j) { const float* wp = cwl + (size_t)j * 1536 + g * 8; const f32x4 a = *(const f32x4*)wp, bq = *(const f32x4*)(wp + 4);
        cw[j][0] = a.x; cw[j][1] = a.y; cw[j][2] = a.z; cw[j][3] = a.w; cw[j][4] = bq.x; cw[j][5] = bq.y; cw[j][6] = bq.z; cw[j][7] = bq.w; }
    float p1[8], p2[8], p3[8], cur[8];
    unpack8(*(const LAS v4u*)(L + slot * 9216 + 0 * 3072 + g * 16), p3); unpack8(*(const LAS v4u*)(L + slot * 9216 + 1 * 3072 + g * 16), p2); unpack8(*(const LAS v4u*)(L + slot * 9216 + 2 * 3072 + g * 16), p1);
    bf16* base = U + (size_t)tile * 64 * NU + U_GQ + g * 8;
#pragma unroll 1
    for (int blk = 0; blk < 8; ++blk) { v4u raw[8];
#pragma unroll
        for (int ii = 0; ii < 8; ++ii) raw[ii] = *(const v4u*)(base + (size_t)(blk * 8 + ii) * NU);
#pragma unroll
        for (int ii = 0; ii < 8; ++ii) { unpack8(raw[ii], cur); float y[8];
#pragma unroll
            for (int c = 0; c < 8; ++c) { const float a = cw[0][c] * p3[c] + cw[1][c] * p2[c] + cw[2][c] * p1[c] + cw[3][c] * cur[c]; y[c] = a * sigmoidf_(a); }
            *(v4u*)(base + (size_t)(blk * 8 + ii) * NU) = pack8(y);
#pragma unroll
            for (int c = 0; c < 8; ++c) { p3[c] = p2[c]; p2[c] = p1[c]; p1[c] = cur[c]; } } }
}

typedef short bf16x8_t __attribute__((ext_vector_type(8)));
typedef float f32x16_t __attribute__((ext_vector_type(16)));
#define MFMA32(a, b, c) __builtin_amdgcn_mfma_f32_32x32x16_bf16((a), (b), (c), 0, 0, 0)
constexpr int PQ = 272, PT = 144, LP = 68;
constexpr int GO_QH = 0, GO_KT = 17408, GO_ST = 35840, GO_KH = 70656, GO_VT = 88064, GO_LF = 106496, GO_T1 = 123904, GO_T2 = GO_T1 + 9216, GO_SC = 142336;
__device__ __forceinline__ bf16x8_t ldfrag(LAS unsigned char* base, int row, int pitch, int kbyte) { return *(const LAS bf16x8_t*)(base + row * pitch + kbyte); }
__device__ __forceinline__ void gdn_prep(LAS unsigned char* L, int unit, int next_unit, v4u (&pre)[8], float& pgb0, float& pgb1, const float* alogl, const float* dtbl, const float* GBA, bf16* U, bf16* Y, bf16* AiBuf, float* ScBuf) {
    const TI F = ti(); const int tid0 = F.tid, wave = F.wave;
    const int bh = unit >> 7, n = unit & 127, b = bh >> 2, h = bh & 3;
    LAS float* SCb = (LAS float*)(L + GO_SC);
    LAS float* Lf = (LAS float*)(L + GO_LF);
    LAS float* part = (LAS float*)(L + GO_T1);
    const int gi = tid0 % 48, run = tid0 / 48;
    const int ucol = gi < 16 ? U_GQ + h * 128 + gi * 8 : (gi < 32 ? U_GK + h * 128 + (gi - 16) * 8 : U_GV + h * 128 + (gi - 32) * 8);
    const float A_neg = -fexp(alogl[h]), dtb = dtbl[h];
    const int mi = wave >> 2, ne = wave & 3, md = wave >> 1, nh = wave & 1;
    const size_t t0 = (size_t)b * SEQ + (size_t)n * 64;
#define REOPQ() int tid = tid0; asm volatile("" : "+v"(tid)); const int lane = tid & 63; int r32 = lane & 31, hi = lane >> 5; (void)lane; (void)r32; (void)hi
#define RELAUNDER() asm volatile("" : "+v"(r32), "+v"(hi))
        { REOPQ();
        if (tid < 384) {
            const int ib = run * 8;
            if (gi < 32) {
#pragma unroll
                for (int ii = 0; ii < 8; ++ii) { float x[8]; unpack8(pre[ii], x); float ss = 0.f;
#pragma unroll
                    for (int c = 0; c < 8; ++c) ss += x[c] * x[c];
                    part[(ib + ii) * 32 + gi] = ss; }
            }
            if (gi < 16) {
#pragma unroll
                for (int ii = 0; ii < 8; ++ii) *(LAS v4u*)(L + GO_QH + (ib + ii) * PQ + gi * 16) = pre[ii];
            } else {
                if (gi < 32) {
#pragma unroll
                    for (int ii = 0; ii < 8; ++ii) *(LAS v4u*)(L + GO_KH + (ib + ii) * PQ + (gi - 16) * 16) = pre[ii];
                }
                LAS unsigned char* tb = gi < 32 ? (L + GO_KT + ((gi - 16) * 8) * PT + ib * 2) : (L + GO_VT + ((gi - 32) * 8) * PT + ib * 2);
#pragma unroll
                for (int c = 0; c < 8; ++c) { v4u o;
                    const unsigned sel = (c & 1) ? 0x07060302u : 0x05040100u;
                    o.x = __builtin_amdgcn_perm(pre[1][c >> 1], pre[0][c >> 1], sel); o.y = __builtin_amdgcn_perm(pre[3][c >> 1], pre[2][c >> 1], sel);
                    o.z = __builtin_amdgcn_perm(pre[5][c >> 1], pre[4][c >> 1], sel); o.w = __builtin_amdgcn_perm(pre[7][c >> 1], pre[6][c >> 1], sel);
                    *(LAS v4u*)(tb + c * PT) = o; }
            }
        }
        if (wave == 7) {
            const float beta = sigmoidf_(pgb0); const float ax = pgb1 + dtb; const float spl = softplusf_(ax);
            float g = A_neg * spl;
#pragma unroll
            for (int o = 1; o < 64; o <<= 1) { const float t = __shfl_up(g, o); if (lane >= o) g += t; }
            const float gl = __shfl(g, 63);
            SCb[lane] = beta; SCb[64 + lane] = g; SCb[128 + lane] = fexp(g); SCb[192 + lane] = fexp(gl - g);
        }
        __syncthreads();
        { const int d = tid >> 2, pt = tid & 3;
          const v4u a = *(const LAS v4u*)(L + GO_KT + d * PT + pt * 32), bq = *(const LAS v4u*)(L + GO_KT + d * PT + pt * 32 + 16);
          bf16* dst = U + (t0 + (d >> 1)) * NU + U_GK + h * 128 + (d & 1) * 64 + pt * 16;
          *(v4u*)dst = a; *(v4u*)(dst + 8) = bq; }
        if (tid < 128) { const int i = tid & 63, w = tid >> 6; const LAS float* pp = part + i * 32 + w * 16; float s = 0.f;
#pragma unroll
            for (int q = 0; q < 4; ++q) { const f32x4 p4 = *(const LAS f32x4*)(pp + q * 4); s += (p4.x + p4.y) + (p4.z + p4.w); }
            float r = rsqrtf(s + 1e-6f);
            if (w == 0) { r *= 0.08838834764831845f; SCb[256 + i] = r; SCb[384 + i] = SCb[128 + i] * r; }
            else { SCb[320 + i] = r; SCb[448 + i] = SCb[192 + i] * r; SCb[512 + i] = SCb[i] * SCb[128 + i] * r; } }
        }
        { REOPQ();
        const int mt = (wave >> 1) & 1, nt = wave & 1; const bool isKK = wave < 4;
        f32x16_t acc2;
#pragma unroll
        for (int r = 0; r < 16; ++r) acc2[r] = 0.f;
        if (isKK ? (mt >= nt) : (mt <= nt)) {
            LAS unsigned char* Bb = isKK ? (L + GO_KH) : (L + GO_QH);
#pragma unroll
            for (int k = 0; k < 8; ++k) acc2 = MFMA32(ldfrag(L + GO_KH, mt * 32 + r32, PQ, k * 32 + hi * 16), ldfrag(Bb, nt * 32 + r32, PQ, k * 32 + hi * 16), acc2);
        }
        __syncthreads();
        RELAUNDER();
        if (isKK) {
            const int j = nt * 32 + r32; const float gcj = SCb[64 + j], rkj = SCb[320 + j];
#pragma unroll
            for (int r = 0; r < 16; ++r) { const int i = mt * 32 + (r & 3) + 8 * (r >> 2) + 4 * hi;
                const float val = (i > j) ? SCb[i] * SCb[320 + i] * rkj * acc2[r] * fexp(SCb[64 + i] - gcj) : 0.f; Lf[i * LP + j] = val; acc2[r] = val; }
            if (mt == nt) { LAS float* LT = (LAS float*)(L + GO_T1) + (mt * 2 + (r32 >> 4)) * 256 + (r32 & 15) * 16;
                const bool up = r32 >= 16;
#pragma unroll
                for (int g2 = 0; g2 < 2; ++g2) *(LAS f32x4*)(LT + 8 * g2 + 4 * hi) = (f32x4){up ? acc2[8 + g2 * 4] : acc2[g2 * 4], up ? acc2[9 + g2 * 4] : acc2[1 + g2 * 4], up ? acc2[10 + g2 * 4] : acc2[2 + g2 * 4], up ? acc2[11 + g2 * 4] : acc2[3 + g2 * 4]}; }
        } else {
            const int i = nt * 32 + r32; const float gci = SCb[64 + i], rqi = SCb[256 + i];
#pragma unroll
            for (int rg = 0; rg < 4; ++rg) { const int j0 = mt * 32 + 8 * rg + 4 * hi; float z[4];
#pragma unroll
                for (int q = 0; q < 4; ++q) { const int j = j0 + q; z[q] = (i >= j) ? rqi * SCb[320 + j] * acc2[rg * 4 + q] * fexp(gci - SCb[64 + j]) : 0.f; }
                *(v2u*)(AiBuf + ((size_t)unit * 64 + i) * 64 + j0) = (v2u){pk2(z[0], z[1]), pk2(z[2], z[3])}; }
        }
        if (tid < 192) ScBuf[(size_t)unit * 192 + tid] = SCb[tid < 64 ? 384 + tid : (tid < 128 ? 448 + (tid - 64) : 128 + (tid - 128))];
        __syncthreads();
        }
        { REOPQ();
        if (wave == 0) { const int b16 = lane >> 4, c = lane & 15; const LAS float* LT = (const LAS float*)(L + GO_T1) + b16 * 256; float s[16];
#pragma unroll
            for (int i = 0; i < 16; ++i) s[i] = (i == c) ? 1.f : 0.f;
#pragma unroll
            for (int j = 0; j < 15; ++j) { const float xj = s[j];
#pragma unroll
                for (int q = (j + 1) / 4; q < 4; ++q) { const f32x4 l4 = *(const LAS f32x4*)(LT + j * 16 + q * 4);
                    if (q * 4 + 0 > j) s[q * 4 + 0] -= l4.x * xj;
                    if (q * 4 + 1 > j) s[q * 4 + 1] -= l4.y * xj;
                    if (q * 4 + 2 > j) s[q * 4 + 2] -= l4.z * xj;
                    if (q * 4 + 3 > j) s[q * 4 + 3] -= l4.w * xj; } }
#pragma unroll
            for (int i = 0; i < 16; ++i) Lf[(b16 * 16 + i) * LP + b16 * 16 + c] = s[i];
        }
        __syncthreads();
        { const int B = tid >> 8, i = (tid >> 4) & 15, c = tid & 15; float m = 0.f;
#pragma unroll
            for (int q = 0; q < 4; ++q) { const f32x4 l4 = *(const LAS f32x4*)(Lf + (B * 32 + 16 + i) * LP + B * 32 + q * 4);
#pragma unroll
                for (int k = 0; k < 4; ++k) m += l4[k] * Lf[(B * 32 + q * 4 + k) * LP + B * 32 + c]; }
            Lf[(B * 32 + i) * LP + B * 32 + 16 + c] = m; }
        __syncthreads();
        { const int B = tid >> 8, i = (tid >> 4) & 15, c = tid & 15; float a = 0.f;
#pragma unroll
            for (int q = 0; q < 4; ++q) { const f32x4 t4 = *(const LAS f32x4*)(Lf + (B * 32 + 16 + i) * LP + B * 32 + 16 + q * 4);
#pragma unroll
                for (int k = 0; k < 4; ++k) a -= t4[k] * Lf[(B * 32 + q * 4 + k) * LP + B * 32 + 16 + c]; }
            Lf[(B * 32 + 16 + i) * LP + B * 32 + c] = a; }
        __syncthreads();
        { const int i = tid >> 4, c2 = (tid & 15) * 2; float m0 = 0.f, m1 = 0.f;
          typedef float f32x2_ __attribute__((ext_vector_type(2)));
#pragma unroll
            for (int q = 0; q < 8; ++q) { const f32x4 l4 = *(const LAS f32x4*)(Lf + (32 + i) * LP + q * 4);
#pragma unroll
                for (int k = 0; k < 4; ++k) { f32x2_ t = *(const LAS f32x2_*)(Lf + (q * 4 + k) * LP + c2);
                    if (q * 4 + k < 16 && c2 >= 16) t = (f32x2_){0.f, 0.f};
                    m0 += l4[k] * t.x; m1 += l4[k] * t.y; } }
            *(LAS f32x2_*)(Lf + i * LP + 32 + c2) = (f32x2_){m0, m1}; }
        __syncthreads();
        { const int i = tid >> 4, c2 = (tid & 15) * 2; float a0 = 0.f, a1 = 0.f;
          typedef float f32x2_ __attribute__((ext_vector_type(2)));
#pragma unroll
            for (int q = 0; q < 8; ++q) { const f32x4 t4 = *(const LAS f32x4*)(Lf + (32 + i) * LP + 32 + q * 4);
#pragma unroll
                for (int k = 0; k < 4; ++k) { const f32x2_ m = *(const LAS f32x2_*)(Lf + (q * 4 + k) * LP + 32 + c2);
                    const float tk = (q * 4 + k >= 16 && i < 16) ? 0.f : t4[k];
                    a0 -= tk * m.x; a1 -= tk * m.y; } }
            *(LAS f32x2_*)(Lf + (32 + i) * LP + c2) = (f32x2_){a0, a1}; }
        __syncthreads();
        { const int i = tid >> 3, j0 = (tid & 7) * 8; float z1[8], z2[8];
#pragma unroll
            for (int q = 0; q < 8; ++q) { const int j = j0 + q; const float t = (j > i) ? 0.f : Lf[i * LP + j]; z1[q] = t * SCb[j]; z2[q] = t * SCb[512 + j]; }
            *(LAS v4u*)(L + GO_T1 + i * PT + j0 * 2) = pack8(z1); *(LAS v4u*)(L + GO_T2 + i * PT + j0 * 2) = pack8(z2); }
        __syncthreads();
        }
        { REOPQ();
        f32x16_t accU, accW;
#pragma unroll
        for (int r = 0; r < 16; ++r) { accU[r] = 0.f; accW[r] = 0.f; }
#pragma unroll
        for (int k = 0; k < 4; ++k) {
            accU = MFMA32(ldfrag(L + GO_T1, mi * 32 + r32, PT, k * 32 + hi * 16), ldfrag(L + GO_VT, ne * 32 + r32, PT, k * 32 + hi * 16), accU);
            accW = MFMA32(ldfrag(L + GO_KT, md * 32 + r32, PT, k * 32 + hi * 16), ldfrag(L + GO_T2, nh * 32 + r32, PT, k * 32 + hi * 16), accW);
        }
        { bf16* yp = Y + (t0 + (mi * 4 + ne) * 8 + (lane >> 3)) * NY + 512 + h * 128 + (lane & 7) * 16;
          v4u u0, u1; u0.x = pk2(accU[0], accU[1]); u0.y = pk2(accU[2], accU[3]); u0.z = pk2(accU[4], accU[5]); u0.w = pk2(accU[6], accU[7]);
          u1.x = pk2(accU[8], accU[9]); u1.y = pk2(accU[10], accU[11]); u1.z = pk2(accU[12], accU[13]); u1.w = pk2(accU[14], accU[15]);
          *(v4u*)yp = u0; *(v4u*)(yp + 8) = u1; }
        { const int i = nh * 32 + r32;
#pragma unroll
          for (int rg = 0; rg < 4; ++rg) { const int d0 = md * 32 + 8 * rg + 4 * hi;
              *(v2u*)(U + (t0 + i) * NU + U_GV + h * 128 + d0) = (v2u){pk2(-accW[rg * 4], -accW[rg * 4 + 1]), pk2(-accW[rg * 4 + 2], -accW[rg * 4 + 3])}; } }
        if (next_unit < 16 * (SEQ / 64)) {
            const int bh2 = next_unit >> 7, n2 = next_unit & 127, b2 = bh2 >> 2, h2 = bh2 & 3; const size_t t2 = (size_t)b2 * SEQ + (size_t)n2 * 64;
            const int ucol2 = gi < 16 ? U_GQ + h2 * 128 + gi * 8 : (gi < 32 ? U_GK + h2 * 128 + (gi - 16) * 8 : U_GV + h2 * 128 + (gi - 32) * 8);
            if (tid < 384) { const bf16* src = U + (t2 + run * 8) * NU + ucol2;
#pragma unroll
                for (int ii = 0; ii < 8; ++ii) pre[ii] = *(const v4u*)(src + (size_t)ii * NU); }
            if (wave == 7) { const float* gb = GBA + (t2 + lane) * 8; pgb0 = gb[h2]; pgb1 = gb[4 + h2]; } }
        __syncthreads();
        }
#undef REOPQ
#undef RELAUNDER
}

__device__ __forceinline__ void gdn_seq(LAS unsigned char* L, int bh, const bf16* U, bf16* Y, const bf16* AiBuf, const float* ScBuf) {
    const TI F = ti(); const int tid0 = F.tid, wave = F.wave;
    const int b = bh >> 2, h = bh & 3;
    LAS float* SCb = (LAS float*)(L + GO_SC);
    f32x16_t accS0, accS1;
#pragma unroll
    for (int r = 0; r < 16; ++r) { accS0[r] = 0.f; accS1[r] = 0.f; }
    { unsigned z = 0u; asm volatile("" : "+v"(z));
      for (int idx = tid0; idx < 34816 / 16; idx += NTHR) *(LAS v4u*)(L + GO_ST + idx * 16) = (v4u){z, z, z, z}; }
    __syncthreads();
    const int mi = wave >> 2, ne = wave & 3, md = wave >> 1, nh = wave & 1;
    v4u pq[2], pw[2], pk[2], pa, pu0, pu1; float psc = 0.f;
#define GDN_SEQ_LOADS(T0, UNIT) do { \
        _Pragma("unroll") for (int k_ = 0; k_ < 2; ++k_) { const int it_ = tid_l + NTHR * k_, row_ = it_ >> 4, g_ = it_ & 15; \
            pq[k_] = *(const v4u*)(U + ((T0) + row_) * NU + U_GQ + h * 128 + g_ * 8); \
            pw[k_] = *(const v4u*)(U + ((T0) + row_) * NU + U_GV + h * 128 + g_ * 8); \
            pk[k_] = *(const v4u*)(U + ((T0) + row_) * NU + U_GK + h * 128 + g_ * 8); } \
        pa = *(const v4u*)(AiBuf + ((size_t)(UNIT) * 64 + (tid_l >> 3)) * 64 + (tid_l & 7) * 8); \
        { const bf16* yp_ = Y + ((T0) + (mi * 4 + ne) * 8 + ((tid_l & 63) >> 3)) * NY + 512 + h * 128 + (tid_l & 7) * 16; pu0 = *(const v4u*)yp_; pu1 = *(const v4u*)(yp_ + 8); } \
        if (tid_l < 192) psc = ScBuf[(size_t)(UNIT) * 192 + tid_l]; } while (0)
    { const int tid_l = tid0; GDN_SEQ_LOADS((size_t)b * SEQ, bh * 128); }
#pragma unroll 1
    for (int n = 0; n < SEQ / 64; ++n) {
        const size_t t0 = (size_t)b * SEQ + (size_t)n * 64;
#define REOPQ() int tid = tid0; asm volatile("" : "+v"(tid)); const int lane = tid & 63; int r32 = lane & 31, hi = lane >> 5; (void)lane; (void)r32; (void)hi
#define RELAUNDER() asm volatile("" : "+v"(r32), "+v"(hi))
        { REOPQ();
#pragma unroll
        for (int k = 0; k < 2; ++k) { const int it = tid + NTHR * k, row = it >> 4, g = it & 15;
            *(LAS v4u*)(L + GO_QH + row * PQ + g * 16) = pq[k];
            *(LAS v4u*)(L + GO_LF + row * PQ + g * 16) = pw[k];
            *(LAS v4u*)(L + GO_KT + (2 * row + (g >> 3)) * PT + (g & 7) * 16) = pk[k]; }
        *(LAS v4u*)(L + GO_KH + (tid >> 3) * PT + (tid & 7) * 16) = pa;
        if (tid < 192) SCb[tid < 64 ? 384 + tid : (tid < 128 ? 448 + (tid - 64) : 128 + (tid - 128))] = psc;
        f32x16_t accU;
#pragma unroll
        for (int r = 0; r < 8; ++r) { accU[r] = (r & 1) ? bfhi(pu0[r >> 1]) : bflo(pu0[r >> 1]); accU[8 + r] = (r & 1) ? bfhi(pu1[r >> 1]) : bflo(pu1[r >> 1]); }
        if (n + 1 < SEQ / 64) { const int tid_l = tid; GDN_SEQ_LOADS(t0 + 64, bh * 128 + n + 1); }
        __syncthreads();
        RELAUNDER();
        f32x16_t accO;
#pragma unroll
        for (int r = 0; r < 16; ++r) accO[r] = 0.f;
#pragma unroll
        for (int k = 0; k < 8; ++k) { const bf16x8_t bq = ldfrag(L + GO_ST, ne * 32 + r32, PQ, k * 32 + hi * 16);
            accU = MFMA32(ldfrag(L + GO_LF, mi * 32 + r32, PQ, k * 32 + hi * 16), bq, accU);
            accO = MFMA32(ldfrag(L + GO_QH, mi * 32 + r32, PQ, k * 32 + hi * 16), bq, accO);
            if ((k & 3) == 3) __builtin_amdgcn_sched_barrier(0); }
        { const int e = ne * 32 + r32;
#pragma unroll
          for (int rg = 0; rg < 4; ++rg) { const int i0 = mi * 32 + 8 * rg + 4 * hi;
              const f32x4 eg4 = *(const LAS f32x4*)(SCb + 384 + i0), dl4 = *(const LAS f32x4*)(SCb + 448 + i0);
              const float v0 = accU[rg * 4], v1 = accU[rg * 4 + 1], v2 = accU[rg * 4 + 2], v3 = accU[rg * 4 + 3];
              accO[rg * 4] *= eg4.x; accO[rg * 4 + 1] *= eg4.y; accO[rg * 4 + 2] *= eg4.z; accO[rg * 4 + 3] *= eg4.w;
              *(LAS v2u*)(L + GO_T1 + e * PT + i0 * 2) = (v2u){pk2(v0, v1), pk2(v2, v3)};
              *(LAS v2u*)(L + GO_VT + e * PT + i0 * 2) = (v2u){pk2(v0 * dl4.x, v1 * dl4.y), pk2(v2 * dl4.z, v3 * dl4.w)}; } }
        __syncthreads();
        RELAUNDER();
#pragma unroll
        for (int k = 0; k < 4; ++k) accO = MFMA32(ldfrag(L + GO_KH, mi * 32 + r32, PT, k * 32 + hi * 16), ldfrag(L + GO_T1, ne * 32 + r32, PT, k * 32 + hi * 16), accO);
        { bf16* yp = Y + t0 * NY + 512 + h * 128 + ne * 32 + r32;
#pragma unroll
          for (int r = 0; r < 16; ++r) { const int i = mi * 32 + (r & 3) + 8 * (r >> 2) + 4 * hi; yp[(size_t)i * NY] = (bf16)f2bf(accO[r]); } }
        { const float gL = SCb[128 + 63];
#pragma unroll
          for (int r = 0; r < 16; ++r) { accS0[r] *= gL; accS1[r] *= gL; }
#pragma unroll
          for (int k = 0; k < 4; ++k) { const bf16x8_t a = ldfrag(L + GO_KT, md * 32 + r32, PT, k * 32 + hi * 16);
              accS0 = MFMA32(a, ldfrag(L + GO_VT, (2 * nh) * 32 + r32, PT, k * 32 + hi * 16), accS0);
              accS1 = MFMA32(a, ldfrag(L + GO_VT, (2 * nh + 1) * 32 + r32, PT, k * 32 + hi * 16), accS1); }
#pragma unroll
          for (int rg = 0; rg < 4; ++rg) { const int d0 = md * 32 + 8 * rg + 4 * hi;
              *(LAS v2u*)(L + GO_ST + ((2 * nh) * 32 + r32) * PQ + d0 * 2) = (v2u){pk2(accS0[rg * 4], accS0[rg * 4 + 1]), pk2(accS0[rg * 4 + 2], accS0[rg * 4 + 3])};
              *(LAS v2u*)(L + GO_ST + ((2 * nh + 1) * 32 + r32) * PQ + d0 * 2) = (v2u){pk2(accS1[rg * 4], accS1[rg * 4 + 1]), pk2(accS1[rg * 4 + 2], accS1[rg * 4 + 3])}; } }
        __syncthreads();
        }
    }
#undef REOPQ
#undef RELAUNDER
#undef GDN_SEQ_LOADS
}

__device__ __forceinline__ void combine_phase(int l, const float* lp, const float* sublnw, const float* gnw, const bf16* OP, const bf16* U, bf16* Y) {
    const TI F = ti();
    const float lambda_init = l == 0 ? 0.2f : 0.35550906759f;
    const float s01 = wave_sum(lp[F.lane] * lp[64 + F.lane]), s23 = wave_sum(lp[128 + F.lane] * lp[192 + F.lane]);
    const float lam = fexp(s01) - fexp(s23) + lambda_init;
    const int hh = F.lane >> 4, j = F.lane & 15;
    float sw[8], gw_[8];
    { const f32x4 a = *(const f32x4*)(sublnw + j * 8), b = *(const f32x4*)(sublnw + j * 8 + 4);
      sw[0] = a.x; sw[1] = a.y; sw[2] = a.z; sw[3] = a.w; sw[4] = b.x; sw[5] = b.y; sw[6] = b.z; sw[7] = b.w;
      const f32x4 c = *(const f32x4*)(gnw + j * 8), d = *(const f32x4*)(gnw + j * 8 + 4);
      gw_[0] = c.x; gw_[1] = c.y; gw_[2] = c.z; gw_[3] = c.w; gw_[4] = d.x; gw_[5] = d.y; gw_[6] = d.z; gw_[7] = d.w; }
    const int gw = obid() * NWAVES + F.wave, NGW = F.G * NWAVES;
    for (int row = gw; row < M; row += NGW) {
        float o0[8], o1[8], z[8], og[8], zg[8];
        unpack8(*(const v4u*)(OP + (size_t)row * 1024 + hh * 256 + j * 8), o0);
        unpack8(*(const v4u*)(OP + (size_t)row * 1024 + hh * 256 + 128 + j * 8), o1);
        unpack8(*(const v4u*)(U + (size_t)row * NU + U_AZ + hh * 128 + j * 8), z);
        unpack8(*(const v4u*)(Y + (size_t)row * NY + 512 + hh * 128 + j * 8), og);
        unpack8(*(const v4u*)(U + (size_t)row * NU + U_GZ + hh * 128 + j * 8), zg);
        float ss = 0.f, sg = 0.f;
#pragma unroll
        for (int c = 0; c < 8; ++c) { o0[c] = o0[c] - lam * o1[c]; ss += o0[c] * o0[c]; sg += og[c] * og[c]; }
#pragma unroll
        for (int o = 1; o < 16; o <<= 1) { ss += __shfl_xor(ss, o); sg += __shfl_xor(sg, o); }
        const float ra = rsqrtf(ss * (1.0f / 128.0f) + 1e-5f) * (1.0f - lambda_init), rg = rsqrtf(sg * (1.0f / 128.0f) + 1e-6f);
        float ya[8], yg[8];
#pragma unroll
        for (int c = 0; c < 8; ++c) { ya[c] = o0[c] * ra * sw[c] * (z[c] * sigmoidf_(z[c])); yg[c] = og[c] * rg * gw_[c] * (zg[c] * sigmoidf_(zg[c])); }
        v4u wa, wg2; wa.x = pk2(ya[0], ya[1]); wa.y = pk2(ya[2], ya[3]); wa.z = pk2(ya[4], ya[5]); wa.w = pk2(ya[6], ya[7]);
        wg2.x = pk2(yg[0], yg[1]); wg2.y = pk2(yg[2], yg[3]); wg2.z = pk2(yg[4], yg[5]); wg2.w = pk2(yg[6], yg[7]);
        *(v4u*)(Y + (size_t)row * NY + hh * 128 + j * 8) = wa;
        *(v4u*)(Y + (size_t)row * NY + 512 + hh * 128 + j * 8) = wg2;
    }
}

#define XB_TMO      128
#define XB_XCNT(j)  (256  + 64 * (j))
#define XB_XSUB(j)  (1280 + 64 * (j))
#define XB_XGEN(j)  (2304 + 64 * (j))
#define XB_TOP      3328
#define XB_TOPGEN   3392
#define XCD_BAR_WORDS 3456
#define XB_SPIN_CAP (1u << 18)

__device__ __forceinline__ unsigned xb_ld(unsigned* p)              { return __hip_atomic_load(p, __ATOMIC_RELAXED, __HIP_MEMORY_SCOPE_AGENT); }
__device__ __forceinline__ unsigned xb_add(unsigned* p, unsigned v) { return __hip_atomic_fetch_add(p, v, __ATOMIC_RELAXED, __HIP_MEMORY_SCOPE_AGENT); }
__device__ __forceinline__ unsigned xb_xcc_id() { return (unsigned)__builtin_amdgcn_s_getreg((3 << 11) | 20) & 0xFu; }
#define XB_SPIN(cond, bar) do { unsigned _sp = 0; while (cond) { __builtin_amdgcn_s_sleep(1); \
    if ((++_sp & 255u) == 0u) { if (xb_ld(&(bar)[XB_TMO])) break; if (_sp > XB_SPIN_CAP) { atomicAdd(&(bar)[XB_TMO], 1u); break; } } } } while (0)

struct XcdBarrier {
    unsigned* bar; unsigned x;
    volatile LAS unsigned* st;
};

__device__ __forceinline__ XcdBarrier xcd_barrier_post(unsigned* bar, volatile LAS unsigned* st) {
    XcdBarrier b; b.bar = bar; b.x = xb_xcc_id(); b.st = st;
    if (threadIdx.x == 0) (void)xb_add(&bar[XB_XCNT(b.x)], 1u);
    return b;
}
__device__ __forceinline__ void xcd_barrier_complete(unsigned* bar, unsigned x, unsigned& nloc, unsigned& nx) {
    const unsigned G = gridDim.x * gridDim.y * gridDim.z;
    unsigned sum, cnt, mine, sp = 0u;
    for (;;) {
        sum = 0u; cnt = 0u; mine = 0u;
#pragma unroll
        for (unsigned j = 0; j < 16; ++j) { const unsigned c = xb_ld(&bar[XB_XCNT(j)]); sum += c; cnt += (c > 0u) ? 1u : 0u; mine = (j == x) ? c : mine; }
        if (sum == G) break;
        __builtin_amdgcn_s_sleep(1);
        if ((++sp & 255u) == 0u) { if (xb_ld(&bar[XB_TMO])) break; if (sp > XB_SPIN_CAP) { atomicAdd(&bar[XB_TMO], 1u); break; } }
    }
    nloc = mine > 0u ? mine : 1u; nx = cnt > 0u ? cnt : 1u;
}

__device__ __forceinline__ void xcd_barrier(const XcdBarrier& b) {
    asm volatile("s_waitcnt vmcnt(0)" ::: "memory");
    __syncthreads();
    if (threadIdx.x == 0) {
        unsigned* bar = b.bar;
        __builtin_amdgcn_s_waitcnt(0);
        unsigned nloc = b.st[0], nx = b.st[1];
        if (nloc == 0u) { xcd_barrier_complete(bar, b.x, nloc, nx); b.st[0] = nloc; b.st[1] = nx; }
        const unsigned old = xb_add(&bar[XB_XSUB(b.x)], 1u);
        const unsigned gen = old / nloc;
        if (old + 1u == (gen + 1u) * nloc) {
            __builtin_amdgcn_fence(__ATOMIC_RELEASE, "agent");
            asm volatile("s_waitcnt vmcnt(0)" ::: "memory");
            const unsigned og = xb_add(&bar[XB_TOP], 1u);
            const unsigned tg = og / nx;
            if (og + 1u == (tg + 1u) * nx) xb_add(&bar[XB_TOPGEN], 1u);
            else XB_SPIN(xb_ld(&bar[XB_TOPGEN]) == tg, bar);
            __builtin_amdgcn_fence(__ATOMIC_ACQUIRE, "agent");
            xb_add(&bar[XB_XGEN(b.x)], 1u);
            asm volatile("s_waitcnt vmcnt(0)" ::: "memory");
        } else {
            XB_SPIN(xb_ld(&bar[XB_XGEN(b.x)]) == gen, bar);
            __builtin_amdgcn_fence(__ATOMIC_ACQUIRE, "agent");
            asm volatile("s_waitcnt vmcnt(0)" ::: "memory");
        }
    }
    __syncthreads();
}

constexpr size_t WS_BAR = 16384;
constexpr int XB_LDS_OFF = 147392;

#define WSP(off) (A->ws + (off))
#define GSYNC() do { KArgP A_ = kargs(); XcdBarrier b_; b_.bar = (unsigned*)(A_->ws + WS_BAR); b_.x = xb_xcc_id(); b_.st = (volatile LAS unsigned*)(L + XB_LDS_OFF); xcd_barrier(b_); } while (0)

template <int l> __device__ __forceinline__ void layer_body(LAS unsigned char* L, unsigned char* lds) {

        { KArgP A = kargs();
          pg8::Gemm g{(const bf16*)WSP(WS_XN), (const bf16*)WSP(WS_WIN) + (size_t)l * NU * DMODEL, M, NU, DMODEL, DMODEL}; pg8::StaticOrder S; S.init(M, NU, ogrid(), obid());
          pg8::EpiBf16<0> E{(bf16*)WSP(WS_U), NU, nullptr, 512, 512, ATT_C2};
          pg8::gemm_phase<pg8::EpiBf16<0>, pg8::StaticOrder, true, true>(L, g, S, E); }
        GSYNC();
        { KArgP A = kargs(); lru_conv_phase(A->in[9] + l * 4 * 512, A->in[10] + l * 512, (const bf16*)WSP(WS_U), (bf16*)WSP(WS_Y)); }
        { KArgP A = kargs(); gdn_halo_load(L, (const bf16*)WSP(WS_U)); }
        GSYNC();
        { KArgP A = kargs(); gdn_conv_inplace(L, (bf16*)WSP(WS_U), A->in[5] + l * 4 * 1536); }
        GSYNC();
        { KArgP A = kargs();
          pg8::Gemm g{(const bf16*)WSP(WS_Y) + 1024, (const bf16*)WSP(WS_WG) + (size_t)l * 1024 * 512, M, 1024, 512, NY}; pg8::StaticOrder S; S.init(M, 1024, ogrid(), obid());
          pg8::EpiGate E{(bf16*)WSP(WS_U) + U_RX, NU, (bf16*)WSP(WS_Y), NY, A->in[12] + l * 1024};
          pg8::gemm_phase<pg8::EpiGate, pg8::StaticOrder, true, true>(L, g, S, E); }
        { v4u pre[8]; float pgb0 = 0.f, pgb1 = 0.f;
#pragma unroll
          for (int ii = 0; ii < 8; ++ii) pre[ii] = (v4u){0u, 0u, 0u, 0u};
          { KArgP A = kargs(); const int u0 = obid(); const TI F = ti();
            if (u0 < 16 * (SEQ / 64)) { const int bh = u0 >> 7, n = u0 & 127, b = bh >> 2, h = bh & 3, gi = F.tid % 48, run = F.tid / 48; const size_t t0 = (size_t)b * SEQ + (size_t)n * 64;
                const int ucol = gi < 16 ? U_GQ + h * 128 + gi * 8 : (gi < 32 ? U_GK + h * 128 + (gi - 16) * 8 : U_GV + h * 128 + (gi - 32) * 8);
                if (F.tid < 384) { const bf16* src = (const bf16*)WSP(WS_U) + (t0 + run * 8) * NU + ucol;
#pragma unroll
                    for (int ii = 0; ii < 8; ++ii) pre[ii] = *(const v4u*)(src + (size_t)ii * NU); }
                if (F.wave == 7) { const float* gb = (const float*)WSP(WS_GBA) + (t0 + F.lane) * 8; pgb0 = gb[h]; pgb1 = gb[4 + h]; } } }
          for (int u = obid(); u < 16 * (SEQ / 64); u += ogrid()) { KArgP A = kargs();
            bf16* aib = (bf16*)(l == 0 ? (unsigned char*)A->out : WSP(WS_WIN)); float* scb = (float*)((unsigned char*)aib + 16 * MiB);
            gdn_prep(L, u, u + ogrid(), pre, pgb0, pgb1, A->in[6] + l * 4, A->in[7] + l * 4, (const float*)WSP(WS_GBA), (bf16*)WSP(WS_U), (bf16*)WSP(WS_Y), aib, scb); } }
        GSYNC();
        for (int g = obid(); g < N_GDN_UNITS; g += ogrid()) { KArgP A = kargs();
            const bf16* aib = (const bf16*)(l == 0 ? (unsigned char*)A->out : WSP(WS_WIN)); const float* scb = (const float*)((const unsigned char*)aib + 16 * MiB);
            gdn_seq(L, g, (const bf16*)WSP(WS_U), (bf16*)WSP(WS_Y), aib, scb); }

        for (;;) {
            volatile LAS int* MISC = (volatile LAS int*)(L + MISC_OFF);
            __syncthreads();
            if (otid() == 0) { KArgP A = kargs(); MISC[0] = (int)atomicAdd((unsigned*)WSP(WS_CTL) + 64 * (l + 1), 1u); }
            __syncthreads();
            const int w = __builtin_amdgcn_readfirstlane(MISC[0]);
            if (w >= N_LRU_UNITS + N_ATT_UNITS) break;
            KArgP A = kargs();
            if (w >= 384 && w < 384 + N_LRU_UNITS) {
                lru_unit(L, w - 384, A->in[13] + l * 512, (const bf16*)WSP(WS_U), (bf16*)WSP(WS_Y));
            } else {
                const int i = w < 384 ? w : w - N_LRU_UNITS, qb = 31 - (i >> 5), bhm = i & 31, b = bhm >> 3, hm = bhm & 7;
                typedef attn2::bf16 abf;
                const abf* U = (const abf*)WSP(WS_U); const size_t r0 = (size_t)b * SEQ;
                attn2::BlockRef<abf, abf> cur{U + (r0 + qb * 256) * NU + U_AQ + hm * 64, U + r0 * NU + U_AK + hm * 64, U + r0 * NU + U_AV + (hm >> 1) * 128,
                                              (abf*)WSP(WS_XN) + (r0 + qb * 256) * 1024 + hm * 128, qb * 256};
                attn2::Seam<abf> S;
                attn2::causal_swa_prime(cur, 1 << 30, (char*)lds, S);
                attn2::causal_swa_block(cur, cur, SEQ, 1 << 30, (char*)lds, S);
            }
        }
        GSYNC();
        { KArgP A = kargs(); combine_phase(l, A->in[3] + l * 256, A->in[4] + l * 128, A->in[8] + l * 128, (const bf16*)WSP(WS_XN), (const bf16*)WSP(WS_U), (bf16*)WSP(WS_Y)); }
        GSYNC();
        { KArgP A = kargs();
          pg8::Gemm g{(const bf16*)WSP(WS_Y), (const bf16*)WSP(WS_WOUT) + (size_t)l * DMODEL * NY, M, DMODEL, NY, NY}; pg8::StaticOrder S; S.init(M, DMODEL, ogrid(), obid());
          pg8::EpiRes E{l == 0 ? A->in[0] : (const float*)A->out, A->out, DMODEL};
          pg8::gemm_phase<pg8::EpiRes, pg8::StaticOrder, true, true>(L, g, S, E); }
        GSYNC();
        if (l == 0) { { KArgP A = kargs(); norm_phase(L, A->out, A->in[2] + (size_t)DMODEL * INC, A->in[1] + DMODEL, (bf16*)WSP(WS_XN), (float*)WSP(WS_GBA)); } GSYNC(); }
        else { KArgP A = kargs();
            final_norm_phase(A->out, A->in[15]);
        }

}

__global__ void __launch_bounds__(NTHR, 2) mega_fwd(Args args) {
    extern __shared__ __attribute__((aligned(16))) unsigned char lds[];
    LAS unsigned char* L = (LAS unsigned char*)lds;

    if (otid() < 2) ((volatile LAS unsigned*)(L + XB_LDS_OFF))[otid()] = 0u;
    { KArgP A = kargs(); if (obid() == 0) for (int i = otid(); i < 8192; i += NTHR) ((unsigned*)WSP(WS_CTL))[i] = 0u; }
    { KArgP A = kargs(); p0_weights(L, A->in[2], A->in[14], A->in[11], (bf16*)WSP(WS_WIN), (bf16*)WSP(WS_WOUT), (bf16*)WSP(WS_WG)); }
    __syncthreads();
    { KArgP A = kargs(); norm_phase(L, A->in[0], A->in[2], A->in[1], (bf16*)WSP(WS_XN), (float*)WSP(WS_GBA)); }
    cg::this_grid().sync();
    { KArgP A = kargs(); (void)xcd_barrier_post((unsigned*)(A->ws + WS_BAR), (volatile LAS unsigned*)(L + XB_LDS_OFF)); }

    layer_body<0>(L, lds);
    layer_body<1>(L, lds);
}

extern "C" void kernel_launch(void* const* d_in, const int* in_sizes, int n_in, void* d_out, int out_size, void* d_ws, size_t ws_size, hipStream_t stream) {
    static int grid = 0;
    if (grid == 0) {
        if (n_in != 16 || out_size != M * DMODEL || ws_size < WS_END) { fprintf(stderr, "kernel_launch: unexpected shapes (n_in %d out %d ws %zu)\n", n_in, out_size, ws_size); grid = -1; return; }
        int dev = 0, cus = 0, per_cu = 0;
        hipGetDevice(&dev); hipDeviceGetAttribute(&cus, hipDeviceAttributeMultiprocessorCount, dev);
        hipFuncSetAttribute((const void*)mega_fwd, hipFuncAttributeMaxDynamicSharedMemorySize, LDS_BYTES);
        hipOccupancyMaxActiveBlocksPerMultiprocessor(&per_cu, (const void*)mega_fwd, NTHR, LDS_BYTES);
        (void)hipGetLastError();
        if (per_cu < 1) { fprintf(stderr, "kernel_launch: occupancy query says %d blocks per CU\n", per_cu); per_cu = 1; }
        grid = cus;
    }
    if (grid < 0) return;
    Args a{};
    for (int i = 0; i < 16; ++i) a.in[i] = (const float*)d_in[i];
    a.out = (float*)d_out; a.ws = (unsigned char*)d_ws;
    void* kargs[] = {&a};
    hipError_t e = hipLaunchCooperativeKernel((const void*)mega_fwd, dim3(grid), dim3(NTHR), kargs, LDS_BYTES, stream);
    if (e != hipSuccess) fprintf(stderr, "cooperative launch failed: %s (grid %d)\n", hipGetErrorString(e), grid);
}
```

```cpp
#include <hip/hip_runtime.h>
#include <hip/hip_bf16.h>
#include <hip/hip_cooperative_groups.h>
#include <cstdio>
#include <cstdint>
#include <cstddef>
__device__ __forceinline__ int otid() { int t = threadIdx.x; asm volatile("" : "+v"(t)); return t; }
__device__ __forceinline__ int obid() { int t = blockIdx.x; asm volatile("" : "+s"(t)); return t; }
__device__ __forceinline__ int ogrid() { int t = gridDim.x; asm volatile("" : "+s"(t)); return t; }
namespace pg8 {
#define PG8_LAS __attribute__((address_space(3)))
typedef unsigned short bf16_t;
typedef short bf16x8 __attribute__((ext_vector_type(8)));
typedef float f32x4 __attribute__((ext_vector_type(4)));
typedef unsigned u32x4 __attribute__((ext_vector_type(4)));
constexpr int BM = 256, BK = 64, HALF = 128, HTB = HALF * BK * 2  , STAGE_BYTES = 8 * HTB, NXCD = 8, WGM = 8;

__host__ __device__ __forceinline__ int lds_byte(int r, int c) { const int st = (r >> 4) * 2 + (c >> 5), rr = r & 15, cc = c & 31, ob = rr * 64 + cc * 2; return st * 1024 + (ob ^ (((ob >> 9) & 1) << 5)); }
__host__ __device__ __forceinline__ void stage_rc(int b, int& R, int& C) { const int st = b / 1024, sb = b % 1024, swz = sb ^ (((sb >> 9) & 1) << 5); R = (st >> 1) * 16 + swz / 64; C = (st & 1) * 32 + (swz % 64) / 2; }
__host__ __device__ __forceinline__ int perm32(int rho) { const int n = rho >> 4, i = rho & 15; return 8 * (i >> 2) + 4 * n + (i & 3); }

struct Unit { int pm, pn; };
struct Gemm { const bf16_t* A; const bf16_t* Bt; int M, N, K, lda; };

struct StaticOrder {
    int nM, nN, nwg, G, c;
    __host__ __device__ void init(int M, int N, int G_, int c_) { nM = M / BM; nN = N / BM; nwg = nM * nN; G = G_; c = c_; }
    __host__ __device__ bool next(int i, Unit& u) const {
        const long L = (long)i * G + c; if (L >= nwg) return false;
        int wgid = (int)L; { const int q = nwg / NXCD, r = nwg % NXCD, xcd = wgid % NXCD, off = wgid / NXCD; wgid = (xcd < r ? xcd * (q + 1) : r * (q + 1) + (xcd - r) * q) + off; }
        const int nig = WGM * nN, gid = wgid / nig, fm = gid * WGM, gsz = (nM - fm) < WGM ? (nM - fm) : WGM;
        u.pm = fm + ((wgid % nig) % gsz); u.pn = (wgid % nig) / gsz; return true;
    }
    __device__ __forceinline__ void a_ready(const Unit&) const {}
    __device__ __forceinline__ void done(const Unit&) const {}
};

__device__ __forceinline__ unsigned cvt_pk_bf16(float lo, float hi) { unsigned r; asm volatile("v_cvt_pk_bf16_f32 %0, %1, %2" : "=v"(r) : "v"(lo), "v"(hi)); return r; }
typedef float f32x2 __attribute__((ext_vector_type(2)));
__device__ __forceinline__ f32x2 gelu_pk(f32x2 v) {
    const f32x2 av = __builtin_elementwise_abs(v), d = av * 0.2316418882f + 1.0f;
    f32x2 t; t.x = __builtin_amdgcn_rcpf(d.x); t.y = __builtin_amdgcn_rcpf(d.y);
    f32x2 q = t * 0.5307027145f + (-0.7265760135f); q = q * t + 0.7107068705f; q = q * t + (-0.142248368f); q = q * t + 0.127414796f; q = q * t;
    const f32x2 s = (v * v) * (-0.72134752044f);
    f32x2 e; e.x = __builtin_amdgcn_exp2f(s.x); e.y = __builtin_amdgcn_exp2f(s.y);
    const f32x2 m = v * (q * e), r = v - m;
    f32x2 o; o.x = v.x < 0.f ? m.x : r.x; o.y = v.y < 0.f ? m.y : r.y; return o;
}

template <int ACT  > struct EpiBf16 {
    static constexpr bool PERM = true, AFTER_DRAIN = false; static_assert(ACT == 0 || ACT == 1, "EpiBf16: ACT is 0 (none) or 1 (gelu_pk)");
    bf16_t* O; int ldc; const float* bias; int split_cols; size_t split_stride; float scale0;
    __device__ __forceinline__ void operator()(const f32x4 (&acc)[2][2][4][2], const Unit& u, int wr, int wc, int fr, int fq) const {
        const int row0 = u.pm * BM + wr * 64 + fr; int colt = u.pn * BM; bf16_t* base = O;
        float sc = 1.f; if (split_cols) { const int t = colt / split_cols; base += (size_t)t * split_stride; colt -= t * split_cols; if (t == 0) sc = scale0; }
        const int col0 = colt + wc * 32 + 8 * fq, bcol0 = u.pn * BM + wc * 32 + 8 * fq;
        f32x4 bv[2][2];
#pragma unroll
        for (int bj = 0; bj < 2; ++bj)
#pragma unroll
            for (int n = 0; n < 2; ++n) bv[bj][n] = bias ? *(const f32x4*)(bias + bcol0 + bj * HALF + 4 * n) : (f32x4){0.f, 0.f, 0.f, 0.f};
#pragma unroll
        for (int ai = 0; ai < 2; ++ai)
#pragma unroll
            for (int m = 0; m < 4; ++m) { bf16_t* rowp = base + (size_t)(row0 + ai * HALF + m * 16) * ldc + col0;
#pragma unroll
                for (int bj = 0; bj < 2; ++bj) { f32x4 v0 = acc[ai][bj][m][0] + bv[bj][0], v1 = acc[ai][bj][m][1] + bv[bj][1];
                    if (ACT == 1) { f32x2 a = gelu_pk((f32x2){v0[0], v0[1]}), b = gelu_pk((f32x2){v0[2], v0[3]}), c = gelu_pk((f32x2){v1[0], v1[1]}), d = gelu_pk((f32x2){v1[2], v1[3]});
                        v0 = (f32x4){a.x, a.y, b.x, b.y}; v1 = (f32x4){c.x, c.y, d.x, d.y}; }
                    v0 = v0 * sc; v1 = v1 * sc; u32x4 w; w.x = cvt_pk_bf16(v0[0], v0[1]); w.y = cvt_pk_bf16(v0[2], v0[3]); w.z = cvt_pk_bf16(v1[0], v1[1]); w.w = cvt_pk_bf16(v1[2], v1[3]);
                    *(u32x4*)(rowp + bj * HALF) = w; } }
    }
};
template <class Epi, class Sched, bool ALIGN_EPI = false, bool SP2 = false>
__device__ __forceinline__ void gemm_phase(PG8_LAS unsigned char* lds, const Gemm g, const Sched& S, const Epi& E) {
    const int tid = otid(), wid = __builtin_amdgcn_readfirstlane(tid >> 6), lane = tid & 63, wr = wid >> 2, wc = wid & 3, fr = lane & 15, fq = lane >> 4;
    const int K = g.K, nt = K / BK;
    unsigned voffA[2], voffB[2];
#pragma unroll
    for (int i = 0; i < 2; ++i) { int R, C; stage_rc(tid * 16 + i * 8192, R, C); const int Rb = Epi::PERM ? ((R & ~31) + perm32(R & 31)) : R;
        voffA[i] = (unsigned)(R * g.lda + C) * 2u; voffB[i] = (unsigned)(Rb * K + C) * 2u; }
    const size_t kstep = (size_t)(BK * 2);
    const size_t hstepB = (size_t)HALF * K * 2; const size_t hstepA = (size_t)HALF * g.lda * 2;
    const size_t tstepA = 2 * hstepA; const size_t tstepB = 2 * hstepB;
    const unsigned ldsw = (unsigned)wid * 1024u;
    const int aoff = lds_byte(wr * 64 + fr, fq * 8), boff = lds_byte(wc * 32 + fr, fq * 8);
#define PG8_SA(b, h) (((b) * 2 + (h)) * HTB)
#define PG8_SB(b, h) ((4 + (b) * 2 + (h)) * HTB)
#define PG8_STAGE(bufoff, gbase, voff) do { _Pragma("unroll") for (int _i = 0; _i < 2; ++_i) \
        __builtin_amdgcn_global_load_lds((const unsigned*)((const char*)(gbase) + (voff)[_i]), (PG8_LAS unsigned*)(lds + (bufoff) + ldsw + _i * 8192), 16, 0, 0); } while (0)
#define PG8_LDA(dst, b, h) do { _Pragma("unroll") for (int m = 0; m < 4; ++m) _Pragma("unroll") for (int k = 0; k < 2; ++k) dst[m][k] = *(const PG8_LAS bf16x8*)(lds + PG8_SA(b, h) + aoff + m * 2048 + k * 1024); } while (0)
#define PG8_LDB(dst, b, h) do { _Pragma("unroll") for (int n = 0; n < 2; ++n) _Pragma("unroll") for (int k = 0; k < 2; ++k) dst[n][k] = *(const PG8_LAS bf16x8*)(lds + PG8_SB(b, h) + boff + n * 2048 + k * 1024); } while (0)
#define PG8_MMA(ai, bj, At, Bt) do { __builtin_amdgcn_s_setprio(1); _Pragma("unroll") for (int m = 0; m < 4; ++m) _Pragma("unroll") for (int n = 0; n < 2; ++n) _Pragma("unroll") for (int k = 0; k < 2; ++k) \
        acc[ai][bj][m][n] = __builtin_amdgcn_mfma_f32_16x16x32_bf16(Bt[n][k], At[m][k], acc[ai][bj][m][n], 0, 0, 0); __builtin_amdgcn_s_setprio(0); } while (0)
#define PG8_WAIT_V(n) asm volatile("s_waitcnt vmcnt(" #n ")" ::: "memory")
#define PG8_WAIT_L(n) asm volatile("s_waitcnt lgkmcnt(" #n ")" ::: "memory")
#define PG8_BAR __builtin_amdgcn_s_barrier()
#define PG8_SCHED __builtin_amdgcn_sched_barrier(0)
    Unit cur, nxt; int ui = 0;
    if (!S.next(0, cur)) return;
    f32x4 acc[2][2][4][2];
#pragma unroll
    for (int a = 0; a < 2; ++a)
#pragma unroll
        for (int b = 0; b < 2; ++b)
#pragma unroll
            for (int m = 0; m < 4; ++m)
#pragma unroll
                for (int n = 0; n < 2; ++n) acc[a][b][m][n] = (f32x4){0.f, 0.f, 0.f, 0.f};
    bf16x8 At[4][2], B0[2][2], B1[2][2];
    const char* cA = (const char*)g.A + (size_t)cur.pm * tstepA; const char* cB = (const char*)g.Bt + (size_t)cur.pn * tstepB;
    S.a_ready(cur);
    if constexpr (SP2) {
        PG8_STAGE(PG8_SB(0, 0), cB, voffB); PG8_STAGE(PG8_SB(0, 1), cB + hstepB, voffB); PG8_STAGE(PG8_SA(0, 0), cA, voffA); PG8_STAGE(PG8_SA(0, 1), cA + hstepA, voffA);
        if (wr == 1) PG8_BAR;
        PG8_WAIT_V(2); PG8_BAR;
        PG8_STAGE(PG8_SB(1, 0), cB + kstep, voffB); PG8_STAGE(PG8_SA(1, 0), cA + kstep, voffA); PG8_STAGE(PG8_SB(1, 1), cB + hstepB + kstep, voffB);
        PG8_WAIT_V(6); PG8_BAR;
    } else {
        PG8_STAGE(PG8_SB(0, 0), cB, voffB); PG8_STAGE(PG8_SA(0, 0), cA, voffA); PG8_STAGE(PG8_SB(0, 1), cB + hstepB, voffB); PG8_STAGE(PG8_SA(0, 1), cA + hstepA, voffA);
        if (wr == 1) PG8_BAR;
        PG8_WAIT_V(4); PG8_BAR;
        PG8_STAGE(PG8_SB(1, 0), cB + kstep, voffB); PG8_STAGE(PG8_SA(1, 0), cA + kstep, voffA); PG8_STAGE(PG8_SB(1, 1), cB + hstepB + kstep, voffB);
        PG8_WAIT_V(6); PG8_BAR;
    }
    for (;;) {
        const bool has_next = S.next(ui + 1, nxt);
        const char* nA = has_next ? (const char*)g.A + (size_t)nxt.pm * tstepA : cA; const char* nB = has_next ? (const char*)g.Bt + (size_t)nxt.pn * tstepB : cB;
        for (int t = 0; t < nt; t += 2) {
            const bool last = (t == nt - 2);
            const char* a1 = cA + (size_t)(t + 1) * kstep;
            const char* a2 = last ? nA : cA + (size_t)(t + 2) * kstep; const char* b2 = last ? nB : cB + (size_t)(t + 2) * kstep;
            const char* a3 = a2 + kstep; const char* b3 = b2 + kstep;
            if (last && has_next) S.a_ready(nxt);
            if constexpr (SP2) {
            PG8_LDB(B0, 0, 0); PG8_LDB(B1, 0, 1); PG8_SCHED; PG8_LDA(At, 0, 0); PG8_STAGE(PG8_SA(1, 1), a1 + hstepA, voffA);
            PG8_WAIT_V(8); PG8_WAIT_L(0); PG8_BAR; PG8_MMA(0, 0, At, B0); PG8_MMA(0, 1, At, B1); PG8_BAR; PG8_SCHED;
            PG8_LDA(At, 0, 1); PG8_STAGE(PG8_SB(0, 0), b2, voffB); PG8_STAGE(PG8_SB(0, 1), b2 + hstepB, voffB); PG8_STAGE(PG8_SA(0, 0), a2, voffA);
            PG8_WAIT_V(8); PG8_WAIT_L(0); PG8_BAR; PG8_MMA(1, 0, At, B0); PG8_MMA(1, 1, At, B1); PG8_BAR; PG8_SCHED;
            PG8_LDB(B0, 1, 0); PG8_LDB(B1, 1, 1); PG8_SCHED; PG8_LDA(At, 1, 0); PG8_STAGE(PG8_SA(0, 1), a2 + hstepA, voffA);
            PG8_WAIT_V(8); PG8_WAIT_L(0); PG8_BAR; PG8_MMA(0, 0, At, B0); PG8_MMA(0, 1, At, B1); PG8_BAR; PG8_SCHED;
            PG8_LDA(At, 1, 1); PG8_STAGE(PG8_SB(1, 0), b3, voffB); PG8_STAGE(PG8_SB(1, 1), b3 + hstepB, voffB); PG8_STAGE(PG8_SA(1, 0), a3, voffA);
            PG8_WAIT_V(8); PG8_WAIT_L(0); PG8_BAR; PG8_MMA(1, 0, At, B0); PG8_MMA(1, 1, At, B1); PG8_BAR; PG8_SCHED;
            } else {
            PG8_LDB(B0, 0, 0); PG8_SCHED; PG8_LDA(At, 0, 0); PG8_STAGE(PG8_SA(1, 1), a1 + hstepA, voffA);
            PG8_WAIT_L(8); PG8_BAR; PG8_WAIT_L(0); PG8_MMA(0, 0, At, B0); PG8_BAR; PG8_SCHED;
            PG8_LDB(B1, 0, 1); PG8_STAGE(PG8_SB(0, 0), b2, voffB);
            PG8_BAR; PG8_WAIT_L(0); PG8_MMA(0, 1, At, B1); PG8_BAR;
            PG8_LDA(At, 0, 1); PG8_STAGE(PG8_SA(0, 0), a2, voffA);
            PG8_BAR; PG8_WAIT_L(0); PG8_MMA(1, 0, At, B0); PG8_BAR; PG8_SCHED;
            PG8_STAGE(PG8_SB(0, 1), b2 + hstepB, voffB);
            PG8_WAIT_V(6); PG8_BAR; PG8_MMA(1, 1, At, B1); PG8_BAR;
            PG8_LDB(B0, 1, 0); PG8_SCHED; PG8_LDA(At, 1, 0); PG8_STAGE(PG8_SA(0, 1), a2 + hstepA, voffA);
            PG8_WAIT_L(8); PG8_BAR; PG8_WAIT_L(0); PG8_MMA(0, 0, At, B0); PG8_BAR; PG8_SCHED;
            PG8_LDB(B1, 1, 1); PG8_STAGE(PG8_SB(1, 0), b3, voffB);
            PG8_BAR; PG8_WAIT_L(0); PG8_MMA(0, 1, At, B1); PG8_BAR;
            PG8_LDA(At, 1, 1); PG8_STAGE(PG8_SA(1, 0), a3, voffA);
            PG8_BAR; PG8_WAIT_L(0); PG8_MMA(1, 0, At, B0); PG8_BAR; PG8_SCHED;
            PG8_STAGE(PG8_SB(1, 1), b3 + hstepB, voffB);
            PG8_WAIT_V(6); PG8_BAR; PG8_MMA(1, 1, At, B1); PG8_BAR;
            }
        }
        if constexpr (ALIGN_EPI) { if (wr == 0) PG8_BAR; }
        if constexpr (!Epi::AFTER_DRAIN) { E(acc, cur, wr, wc, fr, fq); S.done(cur); }
        if (!has_next) break;
#pragma unroll
        for (int a = 0; a < 2; ++a)
#pragma unroll
            for (int b = 0; b < 2; ++b)
#pragma unroll
                for (int m = 0; m < 4; ++m)
#pragma unroll
                    for (int n = 0; n < 2; ++n) acc[a][b][m][n] = (f32x4){0.f, 0.f, 0.f, 0.f};
        cur = nxt; cA = nA; cB = nB; ++ui;
        if constexpr (ALIGN_EPI) { if (wr == 1) PG8_BAR; }
    }
    PG8_WAIT_V(0);
    if constexpr (!ALIGN_EPI) { if (wr == 0) PG8_BAR; }
    PG8_BAR;
    if constexpr (Epi::AFTER_DRAIN) { E.fused(acc, cur, wr, wc, fr, fq, lds, wid, lane); S.done(cur); }
#undef PG8_SA
#undef PG8_SB
#undef PG8_STAGE
#undef PG8_LDA
#undef PG8_LDB
#undef PG8_MMA
#undef PG8_WAIT_V
#undef PG8_WAIT_L
#undef PG8_BAR
#undef PG8_SCHED
}
}
namespace attn2 {
constexpr int D = 128, DQ = 64, PU = 5120, PO = 1024;
constexpr float SCALE = 0.6931471805599453f;
constexpr float THR = 8.f;
constexpr bool WSKIP = false;
constexpr int NW = 8, QBLK = 32, KVBLK = 64, QB = NW * QBLK;
constexpr int SHM_V = KVBLK * D * 2, SHM_K = KVBLK * DQ * 2;
constexpr int LDS_BYTES = 2 * SHM_V + 2 * SHM_K + NW * 64 * 4;

using bf16 = __hip_bfloat16;
typedef short bf16x8 __attribute__((ext_vector_type(8)));
typedef short s16x4 __attribute__((ext_vector_type(4)));
typedef float f32x16 __attribute__((ext_vector_type(16)));
typedef float f32x4 __attribute__((ext_vector_type(4)));
typedef unsigned u32x4 __attribute__((ext_vector_type(4)));
template <class A, class Bt> struct same_t { static constexpr bool v = false; };
template <class A> struct same_t<A, A> { static constexpr bool v = true; };

#define KSWZ(row, colB) ((row) * 128 + ((colB) ^ (((row) & 7) << 4)))
#define SBAR() __builtin_amdgcn_sched_barrier(0)
__device__ __forceinline__ int v_st(int k, int c) { const int kk = (k & ~0xC) | ((k & 4) << 1) | ((k & 8) >> 1); return ((kk >> 3) * 4 + (c >> 5)) * 512 + ((kk & 7) * 32 + (c & 31)) * 2; }
__device__ __forceinline__ int v_rd_base(int lane) { return ((lane & 3) << 3) | (((lane >> 2) & 3) << 6) | (((lane >> 4) & 1) << 5) | (((lane >> 5) & 1) << 8); }
constexpr int v_rd_off(int d0, int ks, int half) { return d0 * 512 + ks * 4096 + half * 2048; }
__device__ __forceinline__ int crow(int r, int hi) { return (r & 3) + 8 * (r >> 2) + 4 * hi; }
__device__ __forceinline__ unsigned cvtpk(float lo, float hi) {
    unsigned r; asm volatile("v_cvt_pk_bf16_f32 %0, %1, %2" : "=v"(r) : "v"(lo), "v"(hi)); return r;
}
__device__ __forceinline__ bf16x8 pack8(f32x4 a, f32x4 b) {
    u32x4 w = {cvtpk(a[0], a[1]), cvtpk(a[2], a[3]), cvtpk(b[0], b[1]), cvtpk(b[2], b[3])};
    return *reinterpret_cast<bf16x8*>(&w);
}
template <class T> __device__ __forceinline__ bf16x8 load8(const T* p) {
    if constexpr (same_t<T, float>::v) { return pack8(*(const f32x4*)p, *(const f32x4*)(p + 4)); }
    else { return *reinterpret_cast<const bf16x8*>(p); }
}
__device__ __forceinline__ void mask_tile(f32x16& p0, f32x16& p1, int dq, unsigned W) {
    const float NEG = -__builtin_inff();
#pragma unroll
    for (int r = 0; r < 16; ++r) {
        const int c = (r & 3) + 8 * (r >> 2);
        if ((unsigned)(dq - c) >= W) p0[r] = NEG;
        if ((unsigned)(dq - c - 32) >= W) p1[r] = NEG;
    }
}
__device__ __forceinline__ void partialSM(f32x16& p0, f32x16& p1, float& m_reg, float& mn, float& alpha) {
    float pmax = p0[0]; for (int r = 1; r < 16; ++r) pmax = fmaxf(pmax, p0[r]); for (int r = 0; r < 16; ++r) pmax = fmaxf(pmax, p1[r]);
    { auto rr = __builtin_amdgcn_permlane32_swap(__float_as_uint(pmax), __float_as_uint(pmax), false, false);
      pmax = fmaxf(__uint_as_float(rr[0]), __uint_as_float(rr[1])); }
    constexpr float C2 = 1.4426950408889634f * SCALE;
    if (__builtin_expect(__all((pmax - m_reg) * SCALE <= THR), 1)) { mn = m_reg; alpha = 1.f; }
    else { mn = fmaxf(m_reg, pmax); alpha = __builtin_amdgcn_exp2f((m_reg - mn) * C2); m_reg = mn; }
    const float mnL = -mn * C2;
    { typedef float f32x2p __attribute__((ext_vector_type(2))); const f32x2p c2v = {C2, C2}, mv = {mnL, mnL};
#pragma unroll
      for (int r = 0; r < 16; r += 2) { f32x2p a = {p0[r], p0[r + 1]}, b = {p1[r], p1[r + 1]}; a = a * c2v + mv; b = b * c2v + mv; p0[r] = a.x; p0[r + 1] = a.y; p1[r] = b.x; p1[r + 1] = b.y; } }
    for (int r = 0; r < 16; ++r) p0[r] = __builtin_amdgcn_exp2f(p0[r]);
}
__device__ __forceinline__ void finishSM(f32x16& p0, f32x16& p1, float alpha, float& l_reg, bf16x8& pa0, bf16x8& pa1, bf16x8& pa2, bf16x8& pa3) {
    for (int r = 0; r < 16; ++r) p1[r] = __builtin_amdgcn_exp2f(p1[r]);
    float ps; { typedef float f32x2p __attribute__((ext_vector_type(2))); f32x2p s2 = {p0[0], p0[1]};
#pragma unroll
      for (int r = 2; r < 16; r += 2) s2 += (f32x2p){p0[r], p0[r + 1]};
#pragma unroll
      for (int r = 0; r < 16; r += 2) s2 += (f32x2p){p1[r], p1[r + 1]};
      ps = s2.x + s2.y; }
    { auto rr = __builtin_amdgcn_permlane32_swap(__float_as_uint(ps), __float_as_uint(ps), false, false);
      ps = __uint_as_float(rr[0]) + __uint_as_float(rr[1]); }
    l_reg = l_reg * alpha + ps;
#define PK4(P, B_, OUT) do { unsigned a0 = cvtpk(P[B_+0], P[B_+1]), a1 = cvtpk(P[B_+2], P[B_+3]);                          \
        unsigned b0 = cvtpk(P[B_+4], P[B_+5]), b1 = cvtpk(P[B_+6], P[B_+7]);                                             \
        auto r0 = __builtin_amdgcn_permlane32_swap(a0, b0, false, false); auto r1 = __builtin_amdgcn_permlane32_swap(a1, b1, false, false); \
        u32x4 w = {r0[0], r1[0], r0[1], r1[1]}; OUT = *reinterpret_cast<bf16x8*>(&w); } while (0)
    PK4(p0, 0, pa0); PK4(p0, 8, pa1); PK4(p1, 0, pa2); PK4(p1, 8, pa3);
#undef PK4
}
template <int KB, bool SK>
__device__ __forceinline__ void qkt(f32x16& p0, f32x16& p1, const char* K_lds, int r32, int hi, const bf16x8* qr, bool act) {
    if (SK && !act) { const float NEG = -__builtin_inff();
#pragma unroll
        for (int r = 0; r < 16; ++r) { p0[r] = NEG; p1[r] = NEG; } return; }
    p0 = f32x16{}; p1 = f32x16{};
    const char* kb[4];
#pragma unroll
    for (int dd = 0; dd < 4; ++dd) kb[dd] = K_lds + KB * SHM_K + KSWZ(r32, (dd * 16 + hi * 8) * 2);
#pragma unroll
    for (int d0 = 0; d0 < 4; ++d0) { const char* a = kb[d0];
        bf16x8 b0 = *reinterpret_cast<const bf16x8*>(a);
        bf16x8 b1 = *reinterpret_cast<const bf16x8*>(a + 32 * 128);
        p0 = __builtin_amdgcn_mfma_f32_32x32x16_bf16(b0, qr[d0], p0, 0, 0, 0);
        p1 = __builtin_amdgcn_mfma_f32_32x32x16_bf16(b1, qr[d0], p1, 0, 0, 0); }
}
template <int VB, bool SK>
__device__ __forceinline__ void pv_tile(f32x16* o, int vb0, bf16x8 pa0, bf16x8 pa1, bf16x8 pa2, bf16x8 pa3, bool act) {
    if (SK && !act) return;
#define TRRD(dst, off) asm volatile("ds_read_b64_tr_b16 %0, %1 offset:%2" : "=&v"(dst) : "v"(vb0), "i"(off) : "memory")
#define PV_D0(d0) do { s16x4 l0, l1, l2, l3, h0, h1, h2, h3; constexpr int b_ = VB * SHM_V + v_rd_off(d0, 0, 0);     \
        TRRD(l0, b_); TRRD(h0, b_ + 2048); TRRD(l1, b_ + 4096); TRRD(h1, b_ + 6144); TRRD(l2, b_ + 8192); TRRD(h2, b_ + 10240); TRRD(l3, b_ + 12288); TRRD(h3, b_ + 14336); \
        asm volatile("s_waitcnt lgkmcnt(0)" ::: "memory"); SBAR();                 \
        o[d0] = __builtin_amdgcn_mfma_f32_32x32x16_bf16(pa0, (bf16x8){l0[0], l0[1], l0[2], l0[3], h0[0], h0[1], h0[2], h0[3]}, o[d0], 0, 0, 0);   \
        o[d0] = __builtin_amdgcn_mfma_f32_32x32x16_bf16(pa1, (bf16x8){l1[0], l1[1], l1[2], l1[3], h1[0], h1[1], h1[2], h1[3]}, o[d0], 0, 0, 0);   \
        o[d0] = __builtin_amdgcn_mfma_f32_32x32x16_bf16(pa2, (bf16x8){l2[0], l2[1], l2[2], l2[3], h2[0], h2[1], h2[2], h2[3]}, o[d0], 0, 0, 0);   \
        o[d0] = __builtin_amdgcn_mfma_f32_32x32x16_bf16(pa3, (bf16x8){l3[0], l3[1], l3[2], l3[3], h3[0], h3[1], h3[2], h3[3]}, o[d0], 0, 0, 0); } while (0)
    PV_D0(0); PV_D0(1); PV_D0(2); PV_D0(3);
#undef PV_D0
#undef TRRD
}

template <int VB>
__device__ __forceinline__ void pv_sm(f32x16* o, int vb0, bf16x8 pa0, bf16x8 pa1, bf16x8 pa2, bf16x8 pa3, f32x16& p0, f32x16& p1, float& m_reg, float& mn, float& alpha) {
    typedef float f32x2p __attribute__((ext_vector_type(2)));
    constexpr float C2 = 1.4426950408889634f * SCALE;
    s16x4 l0, h0, l1, h1, l2, h2, l3, h3;
#define TRRD(dst, off) asm volatile("ds_read_b64_tr_b16 %0, %1 offset:%2" : "=&v"(dst) : "v"(vb0), "i"(off) : "memory")
#define LOADKS(ks) do { constexpr int b_ = VB * SHM_V + (ks) * 4096; TRRD(l0, b_); TRRD(h0, b_ + 2048); TRRD(l1, b_ + 512); TRRD(h1, b_ + 512 + 2048); \
        TRRD(l2, b_ + 1024); TRRD(h2, b_ + 1024 + 2048); TRRD(l3, b_ + 1536); TRRD(h3, b_ + 1536 + 2048); asm volatile("s_waitcnt lgkmcnt(0)" ::: "memory"); SBAR(); } while (0)
#define FRAG(l, h) (bf16x8){l[0], l[1], l[2], l[3], h[0], h[1], h[2], h[3]}
#define MMAKS(pa) do { o[0] = __builtin_amdgcn_mfma_f32_32x32x16_bf16(pa, FRAG(l0, h0), o[0], 0, 0, 0); o[1] = __builtin_amdgcn_mfma_f32_32x32x16_bf16(pa, FRAG(l1, h1), o[1], 0, 0, 0); \
        o[2] = __builtin_amdgcn_mfma_f32_32x32x16_bf16(pa, FRAG(l2, h2), o[2], 0, 0, 0); o[3] = __builtin_amdgcn_mfma_f32_32x32x16_bf16(pa, FRAG(l3, h3), o[3], 0, 0, 0); } while (0)
#define GRP4(nv) do { _Pragma("unroll") for (int g_ = 0; g_ < 4; ++g_) { __builtin_amdgcn_sched_group_barrier(0x008, 1, 0); __builtin_amdgcn_sched_group_barrier(0x002, nv, 0); } } while (0)
    LOADKS(0); MMAKS(pa0);
    float pmax = p0[0];
#pragma unroll
    for (int r = 1; r < 16; ++r) pmax = fmaxf(pmax, p0[r]);
#pragma unroll
    for (int r = 0; r < 16; ++r) pmax = fmaxf(pmax, p1[r]);
    GRP4(5); SBAR();
    LOADKS(1); MMAKS(pa1);
    { auto rr = __builtin_amdgcn_permlane32_swap(__float_as_uint(pmax), __float_as_uint(pmax), false, false);
      pmax = fmaxf(__uint_as_float(rr[0]), __uint_as_float(rr[1])); }
    const bool ok = __all((pmax - m_reg) * SCALE <= THR);
    const float mnew = fmaxf(m_reg, pmax);
    mn = ok ? m_reg : mnew; alpha = ok ? 1.f : __builtin_amdgcn_exp2f((m_reg - mnew) * C2); m_reg = mn;
    const f32x2p c2v = {C2, C2}, mv = {-mn * C2, -mn * C2};
#pragma unroll
    for (int r = 0; r < 16; r += 2) { f32x2p a = {p0[r], p0[r + 1]}; a = a * c2v + mv; p0[r] = a.x; p0[r + 1] = a.y; }
    GRP4(5); SBAR();
    LOADKS(2);
#define MM1(d, pa, l, h) o[d] = __builtin_amdgcn_mfma_f32_32x32x16_bf16(pa, FRAG(l, h), o[d], 0, 0, 0)
#define SH1(r) do { f32x2p b = {p1[r], p1[r + 1]}; b = b * c2v + mv; p1[r] = b.x; p1[r + 1] = b.y; } while (0)
#define EX1(r) p0[r] = __builtin_amdgcn_exp2f(p0[r])
    MM1(0, pa2, l0, h0); SH1(0); SH1(2); SH1(4); SH1(6);
    MM1(1, pa2, l1, h1); SH1(8); SH1(10); SH1(12); SH1(14);
    MM1(2, pa2, l2, h2); EX1(0); EX1(1); EX1(2); EX1(3);
    MM1(3, pa2, l3, h3); EX1(4); EX1(5); EX1(6); EX1(7);
    asm volatile("" : "+v"(p0), "+v"(p1));
    { __builtin_amdgcn_sched_group_barrier(0x008, 1, 0); __builtin_amdgcn_sched_group_barrier(0x402, 4, 0); __builtin_amdgcn_sched_group_barrier(0x008, 1, 0); __builtin_amdgcn_sched_group_barrier(0x402, 4, 0);
      __builtin_amdgcn_sched_group_barrier(0x008, 1, 0); __builtin_amdgcn_sched_group_barrier(0x402, 4, 0); __builtin_amdgcn_sched_group_barrier(0x008, 1, 0); __builtin_amdgcn_sched_group_barrier(0x402, 4, 0); }
    SBAR();
    LOADKS(3);
    MM1(0, pa3, l0, h0); EX1(8); EX1(9);
    MM1(1, pa3, l1, h1); EX1(10); EX1(11);
    MM1(2, pa3, l2, h2); EX1(12); EX1(13);
    MM1(3, pa3, l3, h3); EX1(14); EX1(15);
    asm volatile("" : "+v"(p0));
    { __builtin_amdgcn_sched_group_barrier(0x008, 1, 0); __builtin_amdgcn_sched_group_barrier(0x402, 2, 0); __builtin_amdgcn_sched_group_barrier(0x008, 1, 0); __builtin_amdgcn_sched_group_barrier(0x402, 2, 0);
      __builtin_amdgcn_sched_group_barrier(0x008, 1, 0); __builtin_amdgcn_sched_group_barrier(0x402, 2, 0); __builtin_amdgcn_sched_group_barrier(0x008, 1, 0); __builtin_amdgcn_sched_group_barrier(0x402, 2, 0); }
    SBAR();
#undef MM1
#undef SH1
#undef EX1
#undef TRRD
#undef LOADKS
#undef FRAG
#undef MMAKS
#undef GRP4
}
template <class TIn, class TOut> struct BlockRef { const TIn* Q; const TIn* K; const TIn* V; TOut* O; int P0; };
template <class TIn> struct Seam {
    bf16x8 qr[4];
    bf16x8 st_v0, st_v1, st_k0;
};
__device__ __forceinline__ int swa_jlo(int P0, int W) { const int lowk = P0 - W + 1; return lowk > 0 ? lowk / KVBLK : 0; }
#define ROW(p, k0, rr) ((p) + (size_t)((k0) + (rr)) * PU + sc)
#define ROWK(p, k0) ((p) + (size_t)((k0) + skr) * PU + skc)
#define VMW() asm volatile("s_waitcnt vmcnt(0)" ::: "memory")
#define VMWN(n) asm volatile("s_waitcnt vmcnt(%0)" :: "i"(n) : "memory")
#define SLOAD_H(Kp, Vp, k0) do { S.st_v0 = load8<TIn>(ROW(Vp, k0, sr)); S.st_v1 = load8<TIn>(ROW(Vp, k0, 32 + sr));              \
                         S.st_k0 = load8<TIn>(ROWK(Kp, k0)); } while (0)
#define SWRITE_HK(bf) do { *(bf16x8*)(K_lds + (bf) * SHM_K + kws) = S.st_k0; } while (0)
#define SWRITE_HV(bf) do { *(bf16x8*)(V_lds + (bf) * SHM_V + vst0) = S.st_v0; *(bf16x8*)(V_lds + (bf) * SHM_V + vst1) = S.st_v1; } while (0)
#define SWRITE_H(bf) do { SWRITE_HV(bf); SWRITE_HK(bf); } while (0)
#define SLOAD_F(p, k0) do { S.sf0 = *(const f32x4*)ROW(p, k0, sr); S.sf1 = *(const f32x4*)(ROW(p, k0, sr) + 4);                \
                            S.sf2 = *(const f32x4*)ROW(p, k0, 32 + sr); S.sf3 = *(const f32x4*)(ROW(p, k0, 32 + sr) + 4); } while (0)
#define SWRITE_KF(bf) do { *(bf16x8*)(K_lds + (bf) * SHM_K + kws) = pack8(S.sf0, S.sf1); *(bf16x8*)(K_lds + (bf) * SHM_K + kws + 32 * 256) = pack8(S.sf2, S.sf3); } while (0)
#define SWRITE_VF(bf) do { *(bf16x8*)(V_lds + (bf) * SHM_V + vst0) = pack8(S.sf0, S.sf1); *(bf16x8*)(V_lds + (bf) * SHM_V + vst1) = pack8(S.sf2, S.sf3); } while (0)
template <class TIn, class TOut>
__device__ __forceinline__ void causal_swa_prime(const BlockRef<TIn, TOut>& cur, int W, char* lds, Seam<TIn>& S) {
    constexpr bool F32 = same_t<TIn, float>::v;
    const int tid = otid(), wid = __builtin_amdgcn_readfirstlane(tid >> 6), lane = tid & 63, r32 = lane & 31, hi = lane >> 5;
    const int sr = tid >> 4, sc = (tid & 15) * 8, skr = tid >> 3, skc = (tid & 7) * 8, kws = KSWZ(skr, skc * 2); char* K_lds = lds + 2 * SHM_V;
    const int kb0 = swa_jlo(cur.P0, W) * KVBLK;
    for (int d0 = 0; d0 < 4; ++d0) S.qr[d0] = load8<TIn>(cur.Q + (size_t)(wid * QBLK + r32) * PU + d0 * 16 + hi * 8);
    if constexpr (F32) { SLOAD_F((const float*)cur.K, kb0); VMW(); SWRITE_KF(0); SBAR(); SLOAD_F((const float*)cur.V, kb0); }
    else { SLOAD_H(cur.K, cur.V, kb0); VMW(); SWRITE_HK(0); }
    __syncthreads();
}
template <class TIn, class TOut>
__device__ __forceinline__ void causal_swa_block(const BlockRef<TIn, TOut>& cur, const BlockRef<TIn, TOut>& nxt, int skv, int W, char* lds, Seam<TIn>& S) {
    constexpr bool F32 = same_t<TIn, float>::v;
    const int tid = otid(), wid = __builtin_amdgcn_readfirstlane(tid >> 6), lane = tid & 63, r32 = lane & 31, hi = lane >> 5;
    const int j_lo = swa_jlo(cur.P0, W);
    int j_hi = (cur.P0 + QB - 1) / KVBLK + 1; if (j_hi > skv / KVBLK) j_hi = skv / KVBLK;
    const int NT = j_hi - j_lo;
    const int kbn = swa_jlo(nxt.P0, W) * KVBLK;
    const int qeff = (cur.P0 + wid * QBLK) | 63;
    char* V_lds = lds; char* K_lds = lds + 2 * SHM_V;
    float* ws = (float*)(lds + 2 * SHM_V + 2 * SHM_K) + wid * 64; float* li_l = ws, * al_l = ws + 32;
    float m_reg = -1e30f, l_reg = 0; f32x16 o[4] = {};
    const int sr = tid >> 4, sc = (tid & 15) * 8, vst0 = v_st(sr, sc), vst1 = v_st(32 + sr, sc), skr = tid >> 3, skc = (tid & 7) * 8, kws = KSWZ(skr, skc * 2);
    const int vb0 = (int)(uintptr_t)V_lds + v_rd_base(lane);
    const TIn* Kh = cur.K; const TIn* Vh = cur.V;
#define RESC(a) do { if (__any((a) < 1.f)) { if (hi == 0) al_l[r32] = (a); asm volatile("s_waitcnt lgkmcnt(0)" ::: "memory");              \
                     for (int d_ = 0; d_ < 4; ++d_) for (int r = 0; r < 16; ++r) o[d_][r] *= al_l[crow(r, hi)]; } } while (0)
#define KBASE(t) ((j_lo + (t)) * KVBLK)
#define ACT(t) (KBASE(t) <= qeff)
#define MASKT(P0_, P1_, t) do { if (__builtin_expect(!ACT(t), 0)) { asm volatile("" ::: "memory");     \
        const float NEG_ = -__builtin_inff(); _Pragma("unroll") for (int r_ = 0; r_ < 16; ++r_) { P0_[r_] = NEG_; P1_[r_] = NEG_; } } } while (0)
    constexpr int NQL = F32 ? 16 : 4;
    constexpr bool SK = WSKIP && !F32;
#define SEAM_K0() do { VMWN(NQL); if constexpr (F32) { SWRITE_KF(0); SBAR(); SLOAD_F((const float*)nxt.V, kbn); } else { SWRITE_HK(0); } SBAR(); } while (0)
    f32x16 pA0, pA1, pB0, pB1; float mnA, mnB, alA, alB; bf16x8 pa0, pa1, pa2, pa3;
    if constexpr (F32) { VMW(); SWRITE_VF(0); SBAR(); } else { SWRITE_HV(0); SBAR(); }
    if (NT > 1) { if constexpr (F32) SLOAD_F((const float*)Kh, KBASE(1)); else SLOAD_H(Kh, Vh, KBASE(1)); }
    SBAR(); qkt<0, SK>(pA0, pA1, K_lds, r32, hi, S.qr, ACT(0));
    if constexpr (F32) { if (NT > 1) { VMW(); SWRITE_KF(1); SBAR(); SLOAD_F((const float*)Vh, KBASE(1)); } }
    MASKT(pA0, pA1, 0); partialSM(pA0, pA1, m_reg, mnA, alA);
    if (NT > 1) { VMW(); if constexpr (F32) { SWRITE_VF(1); SBAR(); if (NT > 2) SLOAD_F((const float*)Kh, KBASE(2)); } else SWRITE_H(1); }
    __syncthreads();
#define HALF_STEP(PX0, PX1, mnX, alX, PY0, PY1, alY, t, KB, VB, SB) do {                                                      \
        SBAR(); qkt<KB, SK>(PX0, PX1, K_lds, r32, hi, S.qr, ACT(t));                                             \
        finishSM(PY0, PY1, alY, l_reg, pa0, pa1, pa2, pa3); SBAR();                                                           \
        if ((t) + 1 < NT) { if constexpr (F32) { VMW(); SWRITE_KF(SB); SBAR(); SLOAD_F((const float*)Vh, KBASE((t) + 1)); }  \
                            else { SLOAD_H(Kh, Vh, KBASE((t) + 1)); } SBAR(); }                                               \
        MASKT(PX0, PX1, (t)); pv_sm<VB>(o, vb0, pa0, pa1, pa2, pa3, PX0, PX1, m_reg, mnX, alX);                                                                          \
        __syncthreads();                                                                                                      \
        if ((t) + 1 < NT) { VMW(); if constexpr (F32) { SWRITE_VF(SB); SBAR(); if ((t) + 2 < NT) SLOAD_F((const float*)Kh, KBASE((t) + 2)); } \
                            else { SWRITE_H(SB); } }                                                                          \
        RESC(alX); __syncthreads(); } while (0)
    for (int t = 1; t + 1 < NT; t += 2) {
        HALF_STEP(pB0, pB1, mnB, alB, pA0, pA1, alA, t, 1, 0, 0);
        HALF_STEP(pA0, pA1, mnA, alA, pB0, pB1, alB, t + 1, 0, 1, 1);
    }
    const bool even = (NT & 1) == 0;
    if (even) { SBAR(); qkt<1, SK>(pB0, pB1, K_lds, r32, hi, S.qr, ACT(NT - 1)); SBAR(); }
#define QROW(e) (nxt.Q + (size_t)(wid * QBLK + r32) * D + ((e) >> 1) * 16 + hi * 8 + ((e) & 1) * 4)
    if constexpr (F32) { SLOAD_F((const float*)nxt.K, kbn); SBAR();
#pragma unroll
        for (int e = 0; e < 8; ++e) S.tq[e] = *(const f32x4*)QROW(e); }
    else { SLOAD_H(nxt.K, nxt.V, kbn); SBAR();
#pragma unroll
        for (int d0 = 0; d0 < 4; ++d0) S.qr[d0] = load8<TIn>(nxt.Q + (size_t)(wid * QBLK + r32) * PU + d0 * 16 + hi * 8); }
    SBAR();
    finishSM(pA0, pA1, alA, l_reg, pa0, pa1, pa2, pa3); SBAR();
    if constexpr (F32) {
#pragma unroll
        for (int e = 8; e < 16; ++e) S.tq[e] = *(const f32x4*)QROW(e); SBAR(); }
#undef QROW
    pv_tile<0, SK>(o, vb0, pa0, pa1, pa2, pa3, ACT(even ? NT - 2 : NT - 1));
    if (even) { MASKT(pB0, pB1, NT - 1); partialSM(pB0, pB1, m_reg, mnB, alB); __syncthreads(); RESC(alB);
        finishSM(pB0, pB1, alB, l_reg, pa0, pa1, pa2, pa3); SBAR(); pv_tile<1, SK>(o, vb0, pa0, pa1, pa2, pa3, ACT(NT - 1)); }
    SBAR(); SEAM_K0();
    if (hi == 0) li_l[r32] = l_reg; asm volatile("s_waitcnt lgkmcnt(0)" ::: "memory");
    float rli[16];
#pragma unroll
    for (int r = 0; r < 16; ++r) rli[r] = __builtin_amdgcn_rcpf(li_l[crow(r, hi)]);
    TOut* Ow = cur.O + (size_t)(wid * QBLK) * PO;
#pragma unroll
    for (int r = 0; r < 16; ++r) { const int orow = crow(r, hi);
#pragma unroll
        for (int d0 = 0; d0 < 4; ++d0) { const float v = o[d0][r] * rli[r];
            if constexpr (same_t<TOut, float>::v) { Ow[(size_t)orow * PO + d0 * 32 + r32] = v; }
            else { const float vn = __shfl_xor(v, 1);
                   if ((r32 & 1) == 0) *(unsigned*)(Ow + (size_t)orow * PO + d0 * 32 + r32) = cvtpk(v, vn); } } }
    if constexpr (F32) {
#pragma unroll
        for (int d0 = 0; d0 < 8; ++d0) S.qr[d0] = pack8(S.tq[2 * d0], S.tq[2 * d0 + 1]); }
    __syncthreads();
#undef RESC
#undef KBASE
#undef ACT
#undef MASKT
#undef SEAM_K0
#undef HALF_STEP
}
#undef ROW
#undef VMW
#undef VMWN
#undef SLOAD_H
#undef SWRITE_HK
#undef SWRITE_HV
#undef SWRITE_H
#undef SLOAD_F
#undef SWRITE_KF
#undef SWRITE_VF

}
namespace cg = cooperative_groups;
#define LAS __attribute__((address_space(3)))
typedef unsigned short bf16;
typedef unsigned v4u __attribute__((ext_vector_type(4)));
typedef unsigned v2u __attribute__((ext_vector_type(2)));
typedef float f32x4 __attribute__((ext_vector_type(4)));

constexpr int NWAVES = 8, NTHR = 512;
constexpr int BATCH = 4, SEQ = 8192, DMODEL = 1024, M = BATCH * SEQ;
constexpr int NU = 5120, NY = 1536, INC = 5128;
constexpr int U_AQ = 0, U_AK = 512, U_AV = 1024, U_AZ = 1536, U_GQ = 2048, U_GK = 2560, U_GV = 3072, U_GZ = 3584, U_RX = 4096, U_RZ = 4608;
constexpr size_t MiB = 1u << 20;
constexpr size_t WS_CTL = 0, WS_WIN = 2 * MiB, WS_WOUT = 22 * MiB, WS_WG = 28 * MiB, WS_GBA = 30 * MiB, WS_XN = 32 * MiB, WS_U = 96 * MiB, WS_Y = 416 * MiB, WS_END = 512 * MiB;
constexpr int RING_BYTES = 131072, MISC_OFF = RING_BYTES + 320, LDS_BYTES = 147456;
constexpr float ATT_C2 = 0.125f * 1.4426950408889634f;
constexpr int N_GDN_UNITS = 16, N_LRU_UNITS = 128, N_ATT_UNITS = 1024;

__device__ __forceinline__ unsigned f2bf(float f) { unsigned u = __builtin_bit_cast(unsigned, f); return (u + 0x7fffu + ((u >> 16) & 1u)) >> 16; }
__device__ __forceinline__ unsigned pk2(float lo, float hi) { return f2bf(lo) | (f2bf(hi) << 16); }
__device__ __forceinline__ float bflo(unsigned w) { return __builtin_bit_cast(float, w << 16); }
__device__ __forceinline__ float bfhi(unsigned w) { return __builtin_bit_cast(float, w & 0xffff0000u); }
__device__ __forceinline__ float bf1(bf16 v) { return __builtin_bit_cast(float, (unsigned)v << 16); }
__device__ __forceinline__ float fexp(float x) { return __builtin_amdgcn_exp2f(x * 1.4426950408889634f); }
__device__ __forceinline__ float flog(float x) { return __builtin_amdgcn_logf(x) * 0.6931471805599453f; }
__device__ __forceinline__ float sigmoidf_(float x) { return __builtin_amdgcn_rcpf(1.0f + fexp(-x)); }
__device__ __forceinline__ float softplusf_(float x) {
    if (x > 20.f) return x;
    const float y = fexp(x);
    return y < 0.01f ? y * (1.f - y * (0.5f - y * 0.33333334f)) : flog(1.f + y);
}
__device__ __forceinline__ float wave_sum(float v) {
#pragma unroll
    for (int o = 1; o < 64; o <<= 1) v += __shfl_xor(v, o);
    return v;
}
template <int CTRL> __device__ __forceinline__ float dpp_f(float x) {
    return __builtin_bit_cast(float, __builtin_amdgcn_update_dpp(0, __builtin_bit_cast(int, x), CTRL, 0xF, 0xF, false));
}
__device__ __forceinline__ float row16_sum(float x) {
    x += dpp_f<0x128>(x); x += dpp_f<0x124>(x); x += dpp_f<0x122>(x); x += dpp_f<0x121>(x); return x;
}

struct Args { const float* in[16]; float* out; unsigned char* ws; };

typedef const __attribute__((address_space(4))) Args* KArgP;
__device__ __forceinline__ KArgP kargs() { KArgP p = (KArgP)__builtin_amdgcn_kernarg_segment_ptr(); asm volatile("" : "+s"(p)); return p; }
struct TI { int tid, lane, wave, G; };
__device__ __forceinline__ TI ti() { TI t; t.tid = otid(); t.lane = t.tid & 63; t.wave = __builtin_amdgcn_readfirstlane(t.tid >> 6); t.G = ogrid(); return t; }

namespace pg8 {
struct EpiRes {
    static constexpr bool PERM = false, AFTER_DRAIN = false;
    const float* base; float* out; int ldc;
    __device__ __forceinline__ void operator()(const f32x4 (&acc)[2][2][4][2], const Unit& u, int wr, int wc, int fr, int fq) const {
        const int col0 = u.pn * BM + wc * 32 + 4 * fq;
#pragma unroll
        for (int ai = 0; ai < 2; ++ai)
#pragma unroll
            for (int m = 0; m < 4; ++m) { const size_t off = (size_t)(u.pm * BM + ai * HALF + wr * 64 + m * 16 + fr) * ldc + col0;
#pragma unroll
                for (int bj = 0; bj < 2; ++bj)
#pragma unroll
                    for (int n = 0; n < 2; ++n) { const f32x4 bs = *(const f32x4*)(base + off + bj * HALF + n * 16); *(f32x4*)(out + off + bj * HALF + n * 16) = bs + acc[ai][bj][m][n]; } }
    }
};
struct EpiGate {
    static constexpr bool PERM = true, AFTER_DRAIN = false;
    bf16_t* O0; int ldc0; bf16_t* O1; int ldc1; const float* bias;
    __device__ __forceinline__ void operator()(const f32x4 (&acc)[2][2][4][2], const Unit& u, int wr, int wc, int fr, int fq) const {
        const int row0 = u.pm * BM + wr * 64 + fr; int colt = u.pn * BM; const int t = colt / 512; bf16_t* base = t ? O1 : O0; const int ldc = t ? ldc1 : ldc0; colt -= t * 512;
        const int col0 = colt + wc * 32 + 8 * fq, bcol0 = u.pn * BM + wc * 32 + 8 * fq;
        f32x4 bv[2][2];
#pragma unroll
        for (int bj = 0; bj < 2; ++bj)
#pragma unroll
            for (int n = 0; n < 2; ++n) bv[bj][n] = *(const f32x4*)(bias + bcol0 + bj * HALF + 4 * n);
#pragma unroll
        for (int ai = 0; ai < 2; ++ai)
#pragma unroll
            for (int m = 0; m < 4; ++m) { bf16_t* rowp = base + (size_t)(row0 + ai * HALF + m * 16) * ldc + col0;
#pragma unroll
                for (int bj = 0; bj < 2; ++bj) { const f32x4 v0 = acc[ai][bj][m][0] + bv[bj][0], v1 = acc[ai][bj][m][1] + bv[bj][1];
                    u32x4 w; w.x = cvt_pk_bf16(v0[0], v0[1]); w.y = cvt_pk_bf16(v0[2], v0[3]); w.z = cvt_pk_bf16(v1[0], v1[1]); w.w = cvt_pk_bf16(v1[2], v1[3]);
                    *(u32x4*)(rowp + bj * HALF) = w; } }
    }
};
}

__device__ __forceinline__ void transpose_item(const float* W, int pitch, int K, bf16* WT, LAS float* scr, int kb, int nb, int lane) {
    const int k0 = 64 * kb, n0 = 32 * nb;
#pragma unroll 8
    for (int i = 0; i < 32; ++i) { const int kk = 2 * i + (lane >> 5); scr[kk * 33 + (lane & 31)] = W[(size_t)(k0 + kk) * pitch + n0 + (lane & 31)]; }
    asm volatile("s_waitcnt lgkmcnt(0)" ::: "memory");
    const int c = lane & 7;
#pragma unroll
    for (int j = 0; j < 4; ++j) { const int n = (lane >> 3) + 8 * j; const LAS float* s = scr + (8 * c) * 33 + n;
        v4u o; o.x = pk2(s[0 * 33], s[1 * 33]); o.y = pk2(s[2 * 33], s[3 * 33]); o.z = pk2(s[4 * 33], s[5 * 33]); o.w = pk2(s[6 * 33], s[7 * 33]);
        *(v4u*)(WT + (size_t)(n0 + n) * K + k0 + 8 * c) = o; }
    asm volatile("s_waitcnt lgkmcnt(0)" ::: "memory");
}
__device__ __forceinline__ void p0_weights(LAS unsigned char* lds, const float* w_in, const float* w_out, const float* lru_gate_w, bf16* Wt_in, bf16* Wt_out, bf16* Wt_g) {
    const TI F = ti();
    LAS float* scr = (LAS float*)(lds + F.wave * 16384);
    const int gw = obid() * NWAVES + F.wave, NGW = F.G * NWAVES;
    constexpr int I_A = 16 * 128, I_B = 16 * 32, I_O = 24 * 32, PER_L = I_A + I_B + I_O;
    for (int it = gw; it < 2 * PER_L; it += NGW) {
        const int l = it / PER_L; int r = it % PER_L;
        const float* win = w_in + (size_t)l * DMODEL * INC; bf16* wt = Wt_in + (size_t)l * NU * DMODEL;
        if (r < I_A) { transpose_item(win, INC, DMODEL, wt, scr, r / 128, r % 128, F.lane); continue; } r -= I_A;
        if (r < I_B) { transpose_item(win + 4104, INC, DMODEL, wt + (size_t)4096 * DMODEL, scr, r / 32, r % 32, F.lane); continue; } r -= I_B;
        transpose_item(w_out + (size_t)l * NY * DMODEL, DMODEL, NY, Wt_out + (size_t)l * DMODEL * NY, scr, r / 32, r % 32, F.lane);
    }
    for (int idx = obid() * NTHR + F.tid; idx < 2 * 1024 * 256; idx += F.G * NTHR) {
        const int l = idx >> 18, rem = idx & 262143, n = rem >> 8, k = (rem & 255) * 2;
        const int g = n >> 9, nb = (n >> 7) & 3, e = n & 127, kb = k >> 7, d = k & 127;
        unsigned w = 0u;
        if (kb == nb) { const float* gw_ = lru_gate_w + ((((size_t)(l * 2 + g) * 4 + nb) * 128 + d) * 128 + e); w = pk2(gw_[0], gw_[128]); }
        *(unsigned*)(Wt_g + (size_t)l * 1024 * 512 + (size_t)n * 512 + k) = w;
    }
}

__device__ __forceinline__ void norm_phase(LAS unsigned char* lds, const float* xsrc, const float* win, const float* nw, bf16* XN, float* GBA) {
    const TI F = ti();
    LAS float* wg = (LAS float*)lds;
    for (int idx = F.tid; idx < 8192; idx += NTHR) { const int k = idx >> 3, j = idx & 7; wg[j * 1024 + k] = win[(size_t)k * INC + 4096 + j]; }
    __syncthreads();
    f32x4 wv[4];
#pragma unroll
    for (int j = 0; j < 4; ++j) wv[j] = *(const f32x4*)(nw + 4 * F.lane + 256 * j);
    const int gw = obid() * NWAVES + F.wave, NGW = F.G * NWAVES;
    const int lane = F.lane; const bool b32 = (lane & 32) != 0, b16 = (lane & 16) != 0, b8 = (lane & 8) != 0;
    for (int row0 = gw * 2; row0 < M; row0 += NGW * 2) {
        f32x4 v[2][4]; float s[2];
#pragma unroll
        for (int rr = 0; rr < 2; ++rr) { const f32x4* xr = (const f32x4*)(xsrc + (size_t)(row0 + rr) * DMODEL) + lane; s[rr] = 0.f;
#pragma unroll
            for (int j = 0; j < 4; ++j) { v[rr][j] = xr[64 * j]; s[rr] += (v[rr][j].x * v[rr][j].x + v[rr][j].y * v[rr][j].y) + (v[rr][j].z * v[rr][j].z + v[rr][j].w * v[rr][j].w); } }
#pragma unroll
        for (int rr = 0; rr < 2; ++rr) { const int row = row0 + rr;
            const float r = rsqrtf(wave_sum(s[rr]) * (1.0f / DMODEL) + 1e-6f);
            unsigned long long* o8 = (unsigned long long*)(XN + (size_t)row * DMODEL) + lane;
            float acc[8];
#pragma unroll
            for (int jj = 0; jj < 8; ++jj) acc[jj] = 0.f;
#pragma unroll
            for (int j = 0; j < 4; ++j) {
                const f32x4 hv = v[rr][j] * r * wv[j];
                o8[64 * j] = (unsigned long long)pk2(hv.x, hv.y) | ((unsigned long long)pk2(hv.z, hv.w) << 32);
#pragma unroll
                for (int jj = 0; jj < 8; ++jj) { const f32x4 w4 = *(const LAS f32x4*)(wg + jj * 1024 + 4 * lane + 256 * j);
                    acc[jj] += (hv.x * w4.x + hv.y * w4.y) + (hv.z * w4.z + hv.w * w4.w); }
            }
            float t4[4], u2[2];
#pragma unroll
            for (int k = 0; k < 4; ++k) { const float send = b32 ? acc[k] : acc[k + 4], keep = b32 ? acc[k + 4] : acc[k]; t4[k] = keep + __shfl_xor(send, 32); }
#pragma unroll
            for (int k = 0; k < 2; ++k) { const float send = b16 ? t4[k] : t4[k + 2], keep = b16 ? t4[k + 2] : t4[k]; u2[k] = keep + __shfl_xor(send, 16); }
            float w1; { const float send = b8 ? u2[0] : u2[1], keep = b8 ? u2[1] : u2[0]; w1 = keep + __shfl_xor(send, 8); }
            w1 += __shfl_xor(w1, 4); w1 += __shfl_xor(w1, 2); w1 += __shfl_xor(w1, 1);
            if ((lane & 7) == 0) GBA[(size_t)row * 8 + (lane >> 3)] = w1;
        }
    }
    __syncthreads();
}
__device__ __forceinline__ void final_norm_phase(float* out, const float* fnw) {
    const TI F = ti();
    f32x4 wv[4];
#pragma unroll
    for (int j = 0; j < 4; ++j) wv[j] = *(const f32x4*)(fnw + 4 * F.lane + 256 * j);
    const int gw = obid() * NWAVES + F.wave, NGW = F.G * NWAVES;
    for (int row0 = gw * 2; row0 < M; row0 += NGW * 2) {
        f32x4 v[2][4]; float s[2];
#pragma unroll
        for (int rr = 0; rr < 2; ++rr) { const f32x4* xr = (const f32x4*)(out + (size_t)(row0 + rr) * DMODEL) + F.lane; s[rr] = 0.f;
#pragma unroll
            for (int j = 0; j < 4; ++j) { v[rr][j] = xr[64 * j]; s[rr] += (v[rr][j].x * v[rr][j].x + v[rr][j].y * v[rr][j].y) + (v[rr][j].z * v[rr][j].z + v[rr][j].w * v[rr][j].w); } }
#pragma unroll
        for (int rr = 0; rr < 2; ++rr) { const int row = row0 + rr; f32x4* xr = (f32x4*)(out + (size_t)row * DMODEL) + F.lane;
            const float r = rsqrtf(wave_sum(s[rr]) * (1.0f / DMODEL) + 1e-6f);
#pragma unroll
            for (int j = 0; j < 4; ++j) xr[64 * j] = v[rr][j] * r * wv[j]; }
    }
}

__device__ __forceinline__ void unpack8(const v4u w, float (&f)[8]) {
    f[0] = bflo(w.x); f[1] = bfhi(w.x); f[2] = bflo(w.y); f[3] = bfhi(w.y); f[4] = bflo(w.z); f[5] = bfhi(w.z); f[6] = bflo(w.w); f[7] = bfhi(w.w);
}
__device__ __forceinline__ v4u pack8(const float* y) { v4u o; o.x = pk2(y[0], y[1]); o.y = pk2(y[2], y[3]); o.z = pk2(y[4], y[5]); o.w = pk2(y[6], y[7]); return o; }
__device__ __forceinline__ void lru_conv_phase(const float* cwl, const float* cbl, const bf16* U, bf16* Y) {
    const TI F = ti();
    const int cgp = F.tid & 63, ts = F.tid >> 6, c0 = cgp * 8;
    float w[4][8], bb[8];
#pragma unroll
    for (int j = 0; j < 4; ++j) { const f32x4 a = *(const f32x4*)(cwl + (size_t)j * 512 + c0), b = *(const f32x4*)(cwl + (size_t)j * 512 + c0 + 4);
        w[j][0] = a.x; w[j][1] = a.y; w[j][2] = a.z; w[j][3] = a.w; w[j][4] = b.x; w[j][5] = b.y; w[j][6] = b.z; w[j][7] = b.w; }
    { const f32x4 a = *(const f32x4*)(cbl + c0), b = *(const f32x4*)(cbl + c0 + 4);
      bb[0] = a.x; bb[1] = a.y; bb[2] = a.z; bb[3] = a.w; bb[4] = b.x; bb[5] = b.y; bb[6] = b.z; bb[7] = b.w; }
    for (int tile = obid(); tile < M / 64; tile += F.G) {
        const int row0 = tile * 64 + ts * 8, tin = row0 & (SEQ - 1);
        float p1[8], p2[8], p3[8], cur[8];
        const bf16* src = U + (size_t)row0 * NU + U_RX + c0;
        if (tin == 0) {
#pragma unroll
            for (int c = 0; c < 8; ++c) { p1[c] = 0.f; p2[c] = 0.f; p3[c] = 0.f; }
        } else {
            unpack8(*(const v4u*)(src - 1 * (ptrdiff_t)NU), p1); unpack8(*(const v4u*)(src - 2 * (ptrdiff_t)NU), p2); unpack8(*(const v4u*)(src - 3 * (ptrdiff_t)NU), p3);
        }
#pragma unroll
        for (int i = 0; i < 8; ++i) {
            unpack8(*(const v4u*)(src + (size_t)i * NU), cur);
            float y[8];
#pragma unroll
            for (int c = 0; c < 8; ++c) y[c] = bb[c] + w[0][c] * p3[c] + w[1][c] * p2[c] + w[2][c] * p1[c] + w[3][c] * cur[c];
            v4u o; o.x = pk2(y[0], y[1]); o.y = pk2(y[2], y[3]); o.z = pk2(y[4], y[5]); o.w = pk2(y[6], y[7]);
            *(v4u*)(Y + (size_t)(row0 + i) * NY + 1024 + c0) = o;
#pragma unroll
            for (int c = 0; c < 8; ++c) { p3[c] = p2[c]; p2[c] = p1[c]; p1[c] = cur[c]; }
        }
    }
}

__device__ __forceinline__ void lru_unit(LAS unsigned char* lds, int w, const float* lpl, const bf16* U, bf16* Y) {
    const TI F = ti();
    const int b = w >> 5, c0 = (w & 31) * 16, seg = F.tid >> 4, c = F.tid & 15, ch = c0 + c;
    LAS float* segP = (LAS float*)lds; LAS float* segH = segP + 512;
    const float lp = lpl[ch];
    const float sp = softplusf_(-lp);
    const float c8 = -8.0f * sp;
    const size_t rowb = (size_t)b * SEQ + (size_t)seg * 256;
    const bf16* pxc = Y + rowb * NY + 1024 + ch; const bf16* pg0 = U + rowb * NU + U_RX + ch; const bf16* pg1 = Y + rowb * NY + ch; const bf16* pz = U + rowb * NU + U_RZ + ch;
    float h = 0.f, P = 1.f;
#pragma unroll 4
    for (int t = 0; t < 256; ++t) {
        const float xc = bf1(pxc[(size_t)t * NY]), g0 = bf1(pg0[(size_t)t * NU]), g1 = bf1(pg1[(size_t)t * NY]);
        const float it = sigmoidf_(g0), rt = sigmoidf_(g1), la = c8 * rt, a = fexp(la);
        const float bt = sqrtf(fmaxf(1.0f - a * a, 0.f)) * (it * xc);
        h = a * h + bt; P *= a;
    }
    segP[seg * 16 + c] = P; segH[seg * 16 + c] = h;
    __syncthreads();
    float hin = 0.f;
    for (int s = 0; s < seg; ++s) hin = segP[s * 16 + c] * hin + segH[s * 16 + c];
    h = hin;
    bf16* py = Y + rowb * NY + 1024 + ch;
#pragma unroll 4
    for (int t = 0; t < 256; ++t) {
        const float xc = bf1(pxc[(size_t)t * NY]), g0 = bf1(pg0[(size_t)t * NU]), g1 = bf1(pg1[(size_t)t * NY]), z = bf1(pz[(size_t)t * NU]);
        const float it = sigmoidf_(g0), rt = sigmoidf_(g1), la = c8 * rt, a = fexp(la);
        const float bt = sqrtf(fmaxf(1.0f - a * a, 0.f)) * (it * xc);
        h = a * h + bt;
        py[(size_t)t * NY] = (bf16)f2bf(h * z * sigmoidf_(z));
    }
    __syncthreads();
}

__device__ __forceinline__ void gdn_halo_load(LAS unsigned char* L, const bf16* U) {
    const TI F = ti(); const int bid = obid();
    for (int slot = 0; slot < 2; ++slot) { const int tile = bid + slot * F.G; if (tile >= M / 64) break; const size_t t0 = (size_t)tile * 64;
        for (int idx = F.tid; idx < 576; idx += NTHR) { const int row = idx / 192, g = idx % 192; unsigned z = 0u; asm volatile("" : "+v"(z)); v4u v = (v4u){z, z, z, z};
            if ((t0 & (SEQ - 1)) != 0) v = *(const v4u*)(U + (t0 - 3 + row) * NU + U_GQ + g * 8);
            *(LAS v4u*)(L + slot * 9216 + row * 3072 + g * 16) = v; } }
}
__device__ __forceinline__ void gdn_conv_inplace(LAS unsigned char* L, bf16* U, const float* cwl) {
    const TI F = ti(); const int bid = obid();
    if (F.tid >= 384) return;
    const int slot = F.tid / 192, g = F.tid % 192, tile = bid + slot * F.G;
    if (tile >= M / 64) return;
    float cw[4][8];
#pragma unroll
    for (int j = 0; j < 4; ++j) { const float* wp = cwl + (size_t)j * 1536 + g * 8; const f32x4 a = *(const f32x4*)wp, bq = *(const f32x4*)(wp + 4);
        cw[j][0] = a.x; cw[j][1] = a.y; cw[j][2] = a.z; cw[j][3] = a.w; cw[j][4] = bq.x; cw[j][5] = bq.y; cw[j][6] = bq.z; cw[j][7] = bq.w; }
    float p1[8], p2[8], p3[8], cur[8];
    unpack8(*(const LAS v4u*)(L + slot * 9216 + 0 * 3072 + g * 16), p3); unpack8(*(const LAS v4u*)(L + slot * 9216 + 1 * 3072 + g * 16), p2); unpack8(*(const LAS v4u*)(L + slot * 9216 + 2 * 3072 + g * 16), p1);
    bf16* base = U + (size_t)tile * 64 * NU + U_GQ + g * 8;
#pragma unroll 1
    for (int blk = 0; blk < 8; ++blk) { v4u raw[8];
#pragma unroll
        for (int ii = 0; ii < 8; ++ii) raw[ii] = *(const v4u*)(base + (size_t)(blk * 8 + ii) * NU);
#pragma unroll
        for (int ii = 0; ii < 8; ++ii) { unpack8(raw[ii], cur); float y[8];
#pragma unroll
            for (int c = 0; c < 8; ++c) { const float a = cw[0][c] * p3[c] + cw[1][c] * p2[c] + cw[2][c] * p1[c] + cw[3][c] * cur[c]; y[c] = a * sigmoidf_(a); }
            *(v4u*)(base + (size_t)(blk * 8 + ii) * NU) = pack8(y);
#pragma unroll
            for (int c = 0; c < 8; ++c) { p3[c] = p2[c]; p2[c] = p1[c]; p1[c] = cur[c]; } } }
}

typedef short bf16x8_t __attribute__((ext_vector_type(8)));
typedef float f32x16_t __attribute__((ext_vector_type(16)));
#define MFMA32(a, b, c) __builtin_amdgcn_mfma_f32_32x32x16_bf16((a), (b), (c), 0, 0, 0)
constexpr int PQ = 272, PT = 144, LP = 68;
constexpr int GO_QH = 0, GO_KT = 17408, GO_ST = 35840, GO_KH = 70656, GO_VT = 88064, GO_LF = 106496, GO_T1 = 123904, GO_T2 = GO_T1 + 9216, GO_SC = 142336;
__device__ __forceinline__ bf16x8_t ldfrag(LAS unsigned char* base, int row, int pitch, int kbyte) { return *(const LAS bf16x8_t*)(base + row * pitch + kbyte); }
__device__ __forceinline__ void gdn_prep(LAS unsigned char* L, int unit, int next_unit, v4u (&pre)[8], float& pgb0, float& pgb1, const float* alogl, const float* dtbl, const float* GBA, bf16* U, bf16* Y, bf16* AiBuf, float* ScBuf) {
    const TI F = ti(); const int tid0 = F.tid, wave = F.wave;
    const int bh = unit >> 7, n = unit & 127, b = bh >> 2, h = bh & 3;
    LAS float* SCb = (LAS float*)(L + GO_SC);
    LAS float* Lf = (LAS float*)(L + GO_LF);
    LAS float* part = (LAS float*)(L + GO_T1);
    const int gi = tid0 % 48, run = tid0 / 48;
    const int ucol = gi < 16 ? U_GQ + h * 128 + gi * 8 : (gi < 32 ? U_GK + h * 128 + (gi - 16) * 8 : U_GV + h * 128 + (gi - 32) * 8);
    const float A_neg = -fexp(alogl[h]), dtb = dtbl[h];
    const int mi = wave >> 2, ne = wave & 3, md = wave >> 1, nh = wave & 1;
    const size_t t0 = (size_t)b * SEQ + (size_t)n * 64;
#define REOPQ() int tid = tid0; asm volatile("" : "+v"(tid)); const int lane = tid & 63; int r32 = lane & 31, hi = lane >> 5; (void)lane; (void)r32; (void)hi
#define RELAUNDER() asm volatile("" : "+v"(r32), "+v"(hi))
        { REOPQ();
        if (tid < 384) {
            const int ib = run * 8;
            if (gi < 32) {
#pragma unroll
                for (int ii = 0; ii < 8; ++ii) { float x[8]; unpack8(pre[ii], x); float ss = 0.f;
#pragma unroll
                    for (int c = 0; c < 8; ++c) ss += x[c] * x[c];
                    part[(ib + ii) * 32 + gi] = ss; }
            }
            if (gi < 16) {
#pragma unroll
                for (int ii = 0; ii < 8; ++ii) *(LAS v4u*)(L + GO_QH + (ib + ii) * PQ + gi * 16) = pre[ii];
            } else {
                if (gi < 32) {
#pragma unroll
                    for (int ii = 0; ii < 8; ++ii) *(LAS v4u*)(L + GO_KH + (ib + ii) * PQ + (gi - 16) * 16) = pre[ii];
                }
                LAS unsigned char* tb = gi < 32 ? (L + GO_KT + ((gi - 16) * 8) * PT + ib * 2) : (L + GO_VT + ((gi - 32) * 8) * PT + ib * 2);
#pragma unroll
                for (int c = 0; c < 8; ++c) { v4u o;
                    const unsigned sel = (c & 1) ? 0x07060302u : 0x05040100u;
                    o.x = __builtin_amdgcn_perm(pre[1][c >> 1], pre[0][c >> 1], sel); o.y = __builtin_amdgcn_perm(pre[3][c >> 1], pre[2][c >> 1], sel);
                    o.z = __builtin_amdgcn_perm(pre[5][c >> 1], pre[4][c >> 1], sel); o.w = __builtin_amdgcn_perm(pre[7][c >> 1], pre[6][c >> 1], sel);
                    *(LAS v4u*)(tb + c * PT) = o; }
            }
        }
        if (wave == 7) {
            const float beta = sigmoidf_(pgb0); const float ax = pgb1 + dtb; const float spl = softplusf_(ax);
            float g = A_neg * spl;
#pragma unroll
            for (int o = 1; o < 64; o <<= 1) { const float t = __shfl_up(g, o); if (lane >= o) g += t; }
            const float gl = __shfl(g, 63);
            SCb[lane] = beta; SCb[64 + lane] = g; SCb[128 + lane] = fexp(g); SCb[192 + lane] = fexp(gl - g);
        }
        __syncthreads();
        { const int d = tid >> 2, pt = tid & 3;
          const v4u a = *(const LAS v4u*)(L + GO_KT + d * PT + pt * 32), bq = *(const LAS v4u*)(L + GO_KT + d * PT + pt * 32 + 16);
          bf16* dst = U + (t0 + (d >> 1)) * NU + U_GK + h * 128 + (d & 1) * 64 + pt * 16;
          *(v4u*)dst = a; *(v4u*)(dst + 8) = bq; }
        if (tid < 128) { const int i = tid & 63, w = tid >> 6; const LAS float* pp = part + i * 32 + w * 16; float s = 0.f;
#pragma unroll
            for (int q = 0; q < 4; ++q) { const f32x4 p4 = *(const LAS f32x4*)(pp + q * 4); s += (p4.x + p4.y) + (p4.z + p4.w); }
            float r = rsqrtf(s + 1e-6f);
            if (w == 0) { r *= 0.08838834764831845f; SCb[256 + i] = r; SCb[384 + i] = SCb[128 + i] * r; }
            else { SCb[320 + i] = r; SCb[448 + i] = SCb[192 + i] * r; SCb[512 + i] = SCb[i] * SCb[128 + i] * r; } }
        }
        { REOPQ();
        const int mt = (wave >> 1) & 1, nt = wave & 1; const bool isKK = wave < 4;
        f32x16_t acc2;
#pragma unroll
        for (int r = 0; r < 16; ++r) acc2[r] = 0.f;
        if (isKK ? (mt >= nt) : (mt <= nt)) {
            LAS unsigned char* Bb = isKK ? (L + GO_KH) : (L + GO_QH);
#pragma unroll
            for (int k = 0; k < 8; ++k) acc2 = MFMA32(ldfrag(L + GO_KH, mt * 32 + r32, PQ, k * 32 + hi * 16), ldfrag(Bb, nt * 32 + r32, PQ, k * 32 + hi * 16), acc2);
        }
        __syncthreads();
        RELAUNDER();
        if (isKK) {
            const int j = nt * 32 + r32; const float gcj = SCb[64 + j], rkj = SCb[320 + j];
#pragma unroll
            for (int r = 0; r < 16; ++r) { const int i = mt * 32 + (r & 3) + 8 * (r >> 2) + 4 * hi;
                const float val = (i > j) ? SCb[i] * SCb[320 + i] * rkj * acc2[r] * fexp(SCb[64 + i] - gcj) : 0.f; Lf[i * LP + j] = val; acc2[r] = val; }
            if (mt == nt) { LAS float* LT = (LAS float*)(L + GO_T1) + (mt * 2 + (r32 >> 4)) * 256 + (r32 & 15) * 16;
                const bool up = r32 >= 16;
#pragma unroll
                for (int g2 = 0; g2 < 2; ++g2) *(LAS f32x4*)(LT + 8 * g2 + 4 * hi) = (f32x4){up ? acc2[8 + g2 * 4] : acc2[g2 * 4], up ? acc2[9 + g2 * 4] : acc2[1 + g2 * 4], up ? acc2[10 + g2 * 4] : acc2[2 + g2 * 4], up ? acc2[11 + g2 * 4] : acc2[3 + g2 * 4]}; }
        } else {
            const int i = nt * 32 + r32; const float gci = SCb[64 + i], rqi = SCb[256 + i];
#pragma unroll
            for (int rg = 0; rg < 4; ++rg) { const int j0 = mt * 32 + 8 * rg + 4 * hi; float z[4];
#pragma unroll
                for (int q = 0; q < 4; ++q) { const int j = j0 + q; z[q] = (i >= j) ? rqi * SCb[320 + j] * acc2[rg * 4 + q] * fexp(gci - SCb[64 + j]) : 0.f; }
                *(v2u*)(AiBuf + ((size_t)unit * 64 + i) * 64 + j0) = (v2u){pk2(z[0], z[1]), pk2(z[2], z[3])}; }
        }
        if (tid < 192) ScBuf[(size_t)unit * 192 + tid] = SCb[tid < 64 ? 384 + tid : (tid < 128 ? 448 + (tid - 64) : 128 + (tid - 128))];
        __syncthreads();
        }
        { REOPQ();
        if (wave == 0) { const int b16 = lane >> 4, c = lane & 15; const LAS float* LT = (const LAS float*)(L + GO_T1) + b16 * 256; float s[16];
#pragma unroll
            for (int i = 0; i < 16; ++i) s[i] = (i == c) ? 1.f : 0.f;
#pragma unroll
            for (int j = 0; j < 15; ++j) { const float xj = s[j];
#pragma unroll
                for (int q = (j + 1) / 4; q < 4; ++q) { const f32x4 l4 = *(const LAS f32x4*)(LT + j * 16 + q * 4);
                    if (q * 4 + 0 > j) s[q * 4 + 0] -= l4.x * xj;
                    if (q * 4 + 1 > j) s[q * 4 + 1] -= l4.y * xj;
                    if (q * 4 + 2 > j) s[q * 4 + 2] -= l4.z * xj;
                    if (q * 4 + 3 > j) s[q * 4 + 3] -= l4.w * xj; } }
#pragma unroll
            for (int i = 0; i < 16; ++i) Lf[(b16 * 16 + i) * LP + b16 * 16 + c] = s[i];
        }
        __syncthreads();
        { const int B = tid >> 8, i = (tid >> 4) & 15, c = tid & 15; float m = 0.f;
#pragma unroll
            for (int q = 0; q < 4; ++q) { const f32x4 l4 = *(const LAS f32x4*)(Lf + (B * 32 + 16 + i) * LP + B * 32 + q * 4);
#pragma unroll
                for (int k = 0; k < 4; ++k) m += l4[k] * Lf[(B * 32 + q * 4 + k) * LP + B * 32 + c]; }
            Lf[(B * 32 + i) * LP + B * 32 + 16 + c] = m; }
        __syncthreads();
        { const int B = tid >> 8, i = (tid >> 4) & 15, c = tid & 15; float a = 0.f;
#pragma unroll
            for (int q = 0; q < 4; ++q) { const f32x4 t4 = *(const LAS f32x4*)(Lf + (B * 32 + 16 + i) * LP + B * 32 + 16 + q * 4);
#pragma unroll
                for (int k = 0; k < 4; ++k) a -= t4[k] * Lf[(B * 32 + q * 4 + k) * LP + B * 32 + 16 + c]; }
            Lf[(B * 32 + 16 + i) * LP + B * 32 + c] = a; }
        __syncthreads();
        { const int i = tid >> 4, c2 = (tid & 15) * 2; float m0 = 0.f, m1 = 0.f;
          typedef float f32x2_ __attribute__((ext_vector_type(2)));
#pragma unroll
            for (int q = 0; q < 8; ++q) { const f32x4 l4 = *(const LAS f32x4*)(Lf + (32 + i) * LP + q * 4);
#pragma unroll
                for (int k = 0; k < 4; ++k) { f32x2_ t = *(const LAS f32x2_*)(Lf + (q * 4 + k) * LP + c2);
                    if (q * 4 + k < 16 && c2 >= 16) t = (f32x2_){0.f, 0.f};
                    m0 += l4[k] * t.x; m1 += l4[k] * t.y; } }
            *(LAS f32x2_*)(Lf + i * LP + 32 + c2) = (f32x2_){m0, m1}; }
        __syncthreads();
        { const int i = tid >> 4, c2 = (tid & 15) * 2; float a0 = 0.f, a1 = 0.f;
          typedef float f32x2_ __attribute__((ext_vector_type(2)));
#pragma unroll
            for (int q = 0; q < 8; ++q) { const f32x4 t4 = *(const LAS f32x4*)(Lf + (32 + i) * LP + 32 + q * 4);
#pragma unroll
                for (int k = 0; k < 4; ++k) { const f32x2_ m = *(const LAS f32x2_*)(Lf + (q * 4 + k) * LP + 32 + c2);
                    const float tk = (q * 4 + k >= 16 && i < 16) ? 0.f : t4[k];
                    a0 -= tk * m.x; a1 -= tk * m.y; } }
            *(LAS f32x2_*)(Lf + (32 + i) * LP + c2) = (f32x2_){a0, a1}; }
        __syncthreads();
        { const int i = tid >> 3, j0 = (tid & 7) * 8; float z1[8], z2[8];
#pragma unroll
            for (int q = 0; q < 8; ++q) { const int j = j0 + q; const float t = (j > i) ? 0.f : Lf[i * LP + j]; z1[q] = t * SCb[j]; z2[q] = t * SCb[512 + j]; }
            *(LAS v4u*)(L + GO_T1 + i * PT + j0 * 2) = pack8(z1); *(LAS v4u*)(L + GO_T2 + i * PT + j0 * 2) = pack8(z2); }
        __syncthreads();
        }
        { REOPQ();
        f32x16_t accU, accW;
#pragma unroll
        for (int r = 0; r < 16; ++r) { accU[r] = 0.f; accW[r] = 0.f; }
#pragma unroll
        for (int k = 0; k < 4; ++k) {
            accU = MFMA32(ldfrag(L + GO_T1, mi * 32 + r32, PT, k * 32 + hi * 16), ldfrag(L + GO_VT, ne * 32 + r32, PT, k * 32 + hi * 16), accU);
            accW = MFMA32(ldfrag(L + GO_KT, md * 32 + r32, PT, k * 32 + hi * 16), ldfrag(L + GO_T2, nh * 32 + r32, PT, k * 32 + hi * 16), accW);
        }
        { bf16* yp = Y + (t0 + (mi * 4 + ne) * 8 + (lane >> 3)) * NY + 512 + h * 128 + (lane & 7) * 16;
          v4u u0, u1; u0.x = pk2(accU[0], accU[1]); u0.y = pk2(accU[2], accU[3]); u0.z = pk2(accU[4], accU[5]); u0.w = pk2(accU[6], accU[7]);
          u1.x = pk2(accU[8], accU[9]); u1.y = pk2(accU[10], accU[11]); u1.z = pk2(accU[12], accU[13]); u1.w = pk2(accU[14], accU[15]);
          *(v4u*)yp = u0; *(v4u*)(yp + 8) = u1; }
        { const int i = nh * 32 + r32;
#pragma unroll
          for (int rg = 0; rg < 4; ++rg) { const int d0 = md * 32 + 8 * rg + 4 * hi;
              *(v2u*)(U + (t0 + i) * NU + U_GV + h * 128 + d0) = (v2u){pk2(-accW[rg * 4], -accW[rg * 4 + 1]), pk2(-accW[rg * 4 + 2], -accW[rg * 4 + 3])}; } }
        if (next_unit < 16 * (SEQ / 64)) {
            const int bh2 = next_unit >> 7, n2 = next_unit & 127, b2 = bh2 >> 2, h2 = bh2 & 3; const size_t t2 = (size_t)b2 * SEQ + (size_t)n2 * 64;
            const int ucol2 = gi < 16 ? U_GQ + h2 * 128 + gi * 8 : (gi < 32 ? U_GK + h2 * 128 + (gi - 16) * 8 : U_GV + h2 * 128 + (gi - 32) * 8);
            if (tid < 384) { const bf16* src = U + (t2 + run * 8) * NU + ucol2;
#pragma unroll
                for (int ii = 0; ii < 8; ++ii) pre[ii] = *(const v4u*)(src + (size_t)ii * NU); }
            if (wave == 7) { const float* gb = GBA + (t2 + lane) * 8; pgb0 = gb[h2]; pgb1 = gb[4 + h2]; } }
        __syncthreads();
        }
#undef REOPQ
#undef RELAUNDER
}

__device__ __forceinline__ void gdn_seq(LAS unsigned char* L, int bh, const bf16* U, bf16* Y, const bf16* AiBuf, const float* ScBuf) {
    const TI F = ti(); const int tid0 = F.tid, wave = F.wave;
    const int b = bh >> 2, h = bh & 3;
    LAS float* SCb = (LAS float*)(L + GO_SC);
    f32x16_t accS0, accS1;
#pragma unroll
    for (int r = 0; r < 16; ++r) { accS0[r] = 0.f; accS1[r] = 0.f; }
    { unsigned z = 0u; asm volatile("" : "+v"(z));
      for (int idx = tid0; idx < 34816 / 16; idx += NTHR) *(LAS v4u*)(L + GO_ST + idx * 16) = (v4u){z, z, z, z}; }
    __syncthreads();
    const int mi = wave >> 2, ne = wave & 3, md = wave >> 1, nh = wave & 1;
    v4u pq[2], pw[2], pk[2], pa, pu0, pu1; float psc = 0.f;
#define GDN_SEQ_LOADS(T0, UNIT) do { \
        _Pragma("unroll") for (int k_ = 0; k_ < 2; ++k_) { const int it_ = tid_l + NTHR * k_, row_ = it_ >> 4, g_ = it_ & 15; \
            pq[k_] = *(const v4u*)(U + ((T0) + row_) * NU + U_GQ + h * 128 + g_ * 8); \
            pw[k_] = *(const v4u*)(U + ((T0) + row_) * NU + U_GV + h * 128 + g_ * 8); \
            pk[k_] = *(const v4u*)(U + ((T0) + row_) * NU + U_GK + h * 128 + g_ * 8); } \
        pa = *(const v4u*)(AiBuf + ((size_t)(UNIT) * 64 + (tid_l >> 3)) * 64 + (tid_l & 7) * 8); \
        { const bf16* yp_ = Y + ((T0) + (mi * 4 + ne) * 8 + ((tid_l & 63) >> 3)) * NY + 512 + h * 128 + (tid_l & 7) * 16; pu0 = *(const v4u*)yp_; pu1 = *(const v4u*)(yp_ + 8); } \
        if (tid_l < 192) psc = ScBuf[(size_t)(UNIT) * 192 + tid_l]; } while (0)
    { const int tid_l = tid0; GDN_SEQ_LOADS((size_t)b * SEQ, bh * 128); }
#pragma unroll 1
    for (int n = 0; n < SEQ / 64; ++n) {
        const size_t t0 = (size_t)b * SEQ + (size_t)n * 64;
#define REOPQ() int tid = tid0; asm volatile("" : "+v"(tid)); const int lane = tid & 63; int r32 = lane & 31, hi = lane >> 5; (void)lane; (void)r32; (void)hi
#define RELAUNDER() asm volatile("" : "+v"(r32), "+v"(hi))
        { REOPQ();
#pragma unroll
        for (int k = 0; k < 2; ++k) { const int it = tid + NTHR * k, row = it >> 4, g = it & 15;
            *(LAS v4u*)(L + GO_QH + row * PQ + g * 16) = pq[k];
            *(LAS v4u*)(L + GO_LF + row * PQ + g * 16) = pw[k];
            *(LAS v4u*)(L + GO_KT + (2 * row + (g >> 3)) * PT + (g & 7) * 16) = pk[k]; }
        *(LAS v4u*)(L + GO_KH + (tid >> 3) * PT + (tid & 7) * 16) = pa;
        if (tid < 192) SCb[tid < 64 ? 384 + tid : (tid < 128 ? 448 + (tid - 64) : 128 + (tid - 128))] = psc;
        f32x16_t accU;
#pragma unroll
        for (int r = 0; r < 8; ++r) { accU[r] = (r & 1) ? bfhi(pu0[r >> 1]) : bflo(pu0[r >> 1]); accU[8 + r] = (r & 1) ? bfhi(pu1[r >> 1]) : bflo(pu1[r >> 1]); }
        if (n + 1 < SEQ / 64) { const int tid_l = tid; GDN_SEQ_LOADS(t0 + 64, bh * 128 + n + 1); }
        __syncthreads();
        RELAUNDER();
        f32x16_t accO;
#pragma unroll
        for (int r = 0; r < 16; ++r) accO[r] = 0.f;
#pragma unroll
        for (int k = 0; k < 8; ++k) { const bf16x8_t bq = ldfrag(L + GO_ST, ne * 32 + r32, PQ, k * 32 + hi * 16);
            accU = MFMA32(ldfrag(L + GO_LF, mi * 32 + r32, PQ, k * 32 + hi * 16), bq, accU);
            accO = MFMA32(ldfrag(L + GO_QH, mi * 32 + r32, PQ, k * 32 + hi * 16), bq, accO);
            if ((k & 3) == 3) __builtin_amdgcn_sched_barrier(0); }
        { const int e = ne * 32 + r32;
#pragma unroll
          for (int rg = 0; rg < 4; ++rg) { const int i0 = mi * 32 + 8 * rg + 4 * hi;
              const f32x4 eg4 = *(const LAS f32x4*)(SCb + 384 + i0), dl4 = *(const LAS f32x4*)(SCb + 448 + i0);
              const float v0 = accU[rg * 4], v1 = accU[rg * 4 + 1], v2 = accU[rg * 4 + 2], v3 = accU[rg * 4 + 3];
              accO[rg * 4] *= eg4.x; accO[rg * 4 + 1] *= eg4.y; accO[rg * 4 + 2] *= eg4.z; accO[rg * 4 + 3] *= eg4.w;
              *(LAS v2u*)(L + GO_T1 + e * PT + i0 * 2) = (v2u){pk2(v0, v1), pk2(v2, v3)};
              *(LAS v2u*)(L + GO_VT + e * PT + i0 * 2) = (v2u){pk2(v0 * dl4.x, v1 * dl4.y), pk2(v2 * dl4.z, v3 * dl4.w)}; } }
        __syncthreads();
        RELAUNDER();
#pragma unroll
        for (int k = 0; k < 4; ++k) accO = MFMA32(ldfrag(L + GO_KH, mi * 32 + r32, PT, k * 32 + hi * 16), ldfrag(L + GO_T1, ne * 32 + r32, PT, k * 32 + hi * 16), accO);
        {
          LAS unsigned short* ot = (LAS unsigned short*)(L + GO_QH) + wave * 1024;
#pragma unroll
          for (int r = 0; r < 16; ++r) ot[((r & 3) + 8 * (r >> 2) + 4 * hi) * 32 + r32] = (unsigned short)f2bf(accO[r]);
          asm volatile("s_waitcnt lgkmcnt(0)" ::: "memory");
#pragma unroll
          for (int q = 0; q < 2; ++q) { const int idx = lane + 64 * q, row = idx >> 2, ch = idx & 3;
              const v4u v = *(const LAS v4u*)(ot + row * 32 + ch * 8);
              *(v4u*)(Y + (t0 + mi * 32 + row) * NY + 512 + h * 128 + ne * 32 + ch * 8) = v; } }
        { const float gL = SCb[128 + 63];
#pragma unroll
          for (int r = 0; r < 16; ++r) { accS0[r] *= gL; accS1[r] *= gL; }
#pragma unroll
          for (int k = 0; k < 4; ++k) { const bf16x8_t a = ldfrag(L + GO_KT, md * 32 + r32, PT, k * 32 + hi * 16);
              accS0 = MFMA32(a, ldfrag(L + GO_VT, (2 * nh) * 32 + r32, PT, k * 32 + hi * 16), accS0);
              accS1 = MFMA32(a, ldfrag(L + GO_VT, (2 * nh + 1) * 32 + r32, PT, k * 32 + hi * 16), accS1); }
#pragma unroll
          for (int rg = 0; rg < 4; ++rg) { const int d0 = md * 32 + 8 * rg + 4 * hi;
              *(LAS v2u*)(L + GO_ST + ((2 * nh) * 32 + r32) * PQ + d0 * 2) = (v2u){pk2(accS0[rg * 4], accS0[rg * 4 + 1]), pk2(accS0[rg * 4 + 2], accS0[rg * 4 + 3])};
              *(LAS v2u*)(L + GO_ST + ((2 * nh + 1) * 32 + r32) * PQ + d0 * 2) = (v2u){pk2(accS1[rg * 4], accS1[rg * 4 + 1]), pk2(accS1[rg * 4 + 2], accS1[rg * 4 + 3])}; } }
        __syncthreads();
        }
    }
#undef REOPQ
#undef RELAUNDER
#undef GDN_SEQ_LOADS
}

__device__ __forceinline__ void combine_phase(int l, const float* lp, const float* sublnw, const float* gnw, const bf16* OP, const bf16* U, bf16* Y) {
    const TI F = ti();
    const float lambda_init = l == 0 ? 0.2f : 0.35550906759f;
    const float s01 = wave_sum(lp[F.lane] * lp[64 + F.lane]), s23 = wave_sum(lp[128 + F.lane] * lp[192 + F.lane]);
    const float lam = fexp(s01) - fexp(s23) + lambda_init;
    const int hh = F.lane >> 4, j = F.lane & 15;
    float sw[8], gw_[8];
    { const f32x4 a = *(const f32x4*)(sublnw + j * 8), b = *(const f32x4*)(sublnw + j * 8 + 4);
      sw[0] = a.x; sw[1] = a.y; sw[2] = a.z; sw[3] = a.w; sw[4] = b.x; sw[5] = b.y; sw[6] = b.z; sw[7] = b.w;
      const f32x4 c = *(const f32x4*)(gnw + j * 8), d = *(const f32x4*)(gnw + j * 8 + 4);
      gw_[0] = c.x; gw_[1] = c.y; gw_[2] = c.z; gw_[3] = c.w; gw_[4] = d.x; gw_[5] = d.y; gw_[6] = d.z; gw_[7] = d.w; }
    const int gw = obid() * NWAVES + F.wave, NGW = F.G * NWAVES;
    for (int row = gw; row < M; row += NGW) {
        float o0[8], o1[8], z[8], og[8], zg[8];
        unpack8(*(const v4u*)(OP + (size_t)row * 1024 + hh * 256 + j * 8), o0);
        unpack8(*(const v4u*)(OP + (size_t)row * 1024 + hh * 256 + 128 + j * 8), o1);
        unpack8(*(const v4u*)(U + (size_t)row * NU + U_AZ + hh * 128 + j * 8), z);
        unpack8(*(const v4u*)(Y + (size_t)row * NY + 512 + hh * 128 + j * 8), og);
        unpack8(*(const v4u*)(U + (size_t)row * NU + U_GZ + hh * 128 + j * 8), zg);
        float ss = 0.f, sg = 0.f;
#pragma unroll
        for (int c = 0; c < 8; ++c) { o0[c] = o0[c] - lam * o1[c]; ss += o0[c] * o0[c]; sg += og[c] * og[c]; }
#pragma unroll
        for (int o = 1; o < 16; o <<= 1) { ss += __shfl_xor(ss, o); sg += __shfl_xor(sg, o); }
        const float ra = rsqrtf(ss * (1.0f / 128.0f) + 1e-5f) * (1.0f - lambda_init), rg = rsqrtf(sg * (1.0f / 128.0f) + 1e-6f);
        float ya[8], yg[8];
#pragma unroll
        for (int c = 0; c < 8; ++c) { ya[c] = o0[c] * ra * sw[c] * (z[c] * sigmoidf_(z[c])); yg[c] = og[c] * rg * gw_[c] * (zg[c] * sigmoidf_(zg[c])); }
        v4u wa, wg2; wa.x = pk2(ya[0], ya[1]); wa.y = pk2(ya[2], ya[3]); wa.z = pk2(ya[4], ya[5]); wa.w = pk2(ya[6], ya[7]);
        wg2.x = pk2(yg[0], yg[1]); wg2.y = pk2(yg[2], yg[3]); wg2.z = pk2(yg[4], yg[5]); wg2.w = pk2(yg[6], yg[7]);
        *(v4u*)(Y + (size_t)row * NY + hh * 128 + j * 8) = wa;
        *(v4u*)(Y + (size_t)row * NY + 512 + hh * 128 + j * 8) = wg2;
    }
}

#define XB_TMO      128
#define XB_XCNT(j)  (256  + 64 * (j))
#define XB_XSUB(j)  (1280 + 64 * (j))
#define XB_XGEN(j)  (2304 + 64 * (j))
#define XB_TOP      3328
#define XB_TOPGEN   3392
#define XCD_BAR_WORDS 3456
#define XB_SPIN_CAP (1u << 18)

__device__ __forceinline__ unsigned xb_ld(unsigned* p)              { return __hip_atomic_load(p, __ATOMIC_RELAXED, __HIP_MEMORY_SCOPE_AGENT); }
__device__ __forceinline__ unsigned xb_add(unsigned* p, unsigned v) { return __hip_atomic_fetch_add(p, v, __ATOMIC_RELAXED, __HIP_MEMORY_SCOPE_AGENT); }
__device__ __forceinline__ unsigned xb_xcc_id() { return (unsigned)__builtin_amdgcn_s_getreg((3 << 11) | 20) & 0xFu; }
#define XB_SPIN(cond, bar) do { unsigned _sp = 0; while (cond) { __builtin_amdgcn_s_sleep(1); \
    if ((++_sp & 255u) == 0u) { if (xb_ld(&(bar)[XB_TMO])) break; if (_sp > XB_SPIN_CAP) { atomicAdd(&(bar)[XB_TMO], 1u); break; } } } } while (0)

struct XcdBarrier {
    unsigned* bar; unsigned x;
    volatile LAS unsigned* st;
};

__device__ __forceinline__ XcdBarrier xcd_barrier_post(unsigned* bar, volatile LAS unsigned* st) {
    XcdBarrier b; b.bar = bar; b.x = xb_xcc_id(); b.st = st;
    if (threadIdx.x == 0) (void)xb_add(&bar[XB_XCNT(b.x)], 1u);
    return b;
}
__device__ __forceinline__ void xcd_barrier_complete(unsigned* bar, unsigned x, unsigned& nloc, unsigned& nx) {
    const unsigned G = gridDim.x * gridDim.y * gridDim.z;
    unsigned sum, cnt, mine, sp = 0u;
    for (;;) {
        sum = 0u; cnt = 0u; mine = 0u;
#pragma unroll
        for (unsigned j = 0; j < 16; ++j) { const unsigned c = xb_ld(&bar[XB_XCNT(j)]); sum += c; cnt += (c > 0u) ? 1u : 0u; mine = (j == x) ? c : mine; }
        if (sum == G) break;
        __builtin_amdgcn_s_sleep(1);
        if ((++sp & 255u) == 0u) { if (xb_ld(&bar[XB_TMO])) break; if (sp > XB_SPIN_CAP) { atomicAdd(&bar[XB_TMO], 1u); break; } }
    }
    nloc = mine > 0u ? mine : 1u; nx = cnt > 0u ? cnt : 1u;
}

__device__ __forceinline__ void xcd_barrier(const XcdBarrier& b) {
    asm volatile("s_waitcnt vmcnt(0)" ::: "memory");
    __syncthreads();
    if (threadIdx.x == 0) {
        unsigned* bar = b.bar;
        __builtin_amdgcn_s_waitcnt(0);
        unsigned nloc = b.st[0], nx = b.st[1];
        if (nloc == 0u) { xcd_barrier_complete(bar, b.x, nloc, nx); b.st[0] = nloc; b.st[1] = nx; }
        const unsigned old = xb_add(&bar[XB_XSUB(b.x)], 1u);
        const unsigned gen = old / nloc;
        if (old + 1u == (gen + 1u) * nloc) {
            __builtin_amdgcn_fence(__ATOMIC_RELEASE, "agent");
            asm volatile("s_waitcnt vmcnt(0)" ::: "memory");
            const unsigned og = xb_add(&bar[XB_TOP], 1u);
            const unsigned tg = og / nx;
            if (og + 1u == (tg + 1u) * nx) xb_add(&bar[XB_TOPGEN], 1u);
            else XB_SPIN(xb_ld(&bar[XB_TOPGEN]) == tg, bar);
            __builtin_amdgcn_fence(__ATOMIC_ACQUIRE, "agent");
            xb_add(&bar[XB_XGEN(b.x)], 1u);
            asm volatile("s_waitcnt vmcnt(0)" ::: "memory");
        } else {
            XB_SPIN(xb_ld(&bar[XB_XGEN(b.x)]) == gen, bar);
            __builtin_amdgcn_fence(__ATOMIC_ACQUIRE, "agent");
            asm volatile("s_waitcnt vmcnt(0)" ::: "memory");
        }
    }
    __syncthreads();
}

constexpr size_t WS_BAR = 16384;
constexpr int XB_LDS_OFF = 147392;

#define WSP(off) (A->ws + (off))
#define GSYNC() do { KArgP A_ = kargs(); XcdBarrier b_; b_.bar = (unsigned*)(A_->ws + WS_BAR); b_.x = xb_xcc_id(); b_.st = (volatile LAS unsigned*)(L + XB_LDS_OFF); xcd_barrier(b_); } while (0)

template <int l> __device__ __forceinline__ void layer_body(LAS unsigned char* L, unsigned char* lds) {

        { KArgP A = kargs();
          pg8::Gemm g{(const bf16*)WSP(WS_XN), (const bf16*)WSP(WS_WIN) + (size_t)l * NU * DMODEL, M, NU, DMODEL, DMODEL}; pg8::StaticOrder S; S.init(M, NU, ogrid(), obid());
          pg8::EpiBf16<0> E{(bf16*)WSP(WS_U), NU, nullptr, 512, 512, ATT_C2};
          pg8::gemm_phase<pg8::EpiBf16<0>, pg8::StaticOrder, true, true>(L, g, S, E); }
        GSYNC();
        { KArgP A = kargs(); lru_conv_phase(A->in[9] + l * 4 * 512, A->in[10] + l * 512, (const bf16*)WSP(WS_U), (bf16*)WSP(WS_Y)); }
        { KArgP A = kargs(); gdn_halo_load(L, (const bf16*)WSP(WS_U)); }
        GSYNC();
        { KArgP A = kargs(); gdn_conv_inplace(L, (bf16*)WSP(WS_U), A->in[5] + l * 4 * 1536); }
        GSYNC();
        { KArgP A = kargs();
          pg8::Gemm g{(const bf16*)WSP(WS_Y) + 1024, (const bf16*)WSP(WS_WG) + (size_t)l * 1024 * 512, M, 1024, 512, NY}; pg8::StaticOrder S; S.init(M, 1024, ogrid(), obid());
          pg8::EpiGate E{(bf16*)WSP(WS_U) + U_RX, NU, (bf16*)WSP(WS_Y), NY, A->in[12] + l * 1024};
          pg8::gemm_phase<pg8::EpiGate, pg8::StaticOrder, true, true>(L, g, S, E); }
        { v4u pre[8]; float pgb0 = 0.f, pgb1 = 0.f;
#pragma unroll
          for (int ii = 0; ii < 8; ++ii) pre[ii] = (v4u){0u, 0u, 0u, 0u};
          { KArgP A = kargs(); const int u0 = obid(); const TI F = ti();
            if (u0 < 16 * (SEQ / 64)) { const int bh = u0 >> 7, n = u0 & 127, b = bh >> 2, h = bh & 3, gi = F.tid % 48, run = F.tid / 48; const size_t t0 = (size_t)b * SEQ + (size_t)n * 64;
                const int ucol = gi < 16 ? U_GQ + h * 128 + gi * 8 : (gi < 32 ? U_GK + h * 128 + (gi - 16) * 8 : U_GV + h * 128 + (gi - 32) * 8);
                if (F.tid < 384) { const bf16* src = (const bf16*)WSP(WS_U) + (t0 + run * 8) * NU + ucol;
#pragma unroll
                    for (int ii = 0; ii < 8; ++ii) pre[ii] = *(const v4u*)(src + (size_t)ii * NU); }
                if (F.wave == 7) { const float* gb = (const float*)WSP(WS_GBA) + (t0 + F.lane) * 8; pgb0 = gb[h]; pgb1 = gb[4 + h]; } } }
          for (int u = obid(); u < 16 * (SEQ / 64); u += ogrid()) { KArgP A = kargs();
            bf16* aib = (bf16*)(l == 0 ? (unsigned char*)A->out : WSP(WS_WIN)); float* scb = (float*)((unsigned char*)aib + 16 * MiB);
            gdn_prep(L, u, u + ogrid(), pre, pgb0, pgb1, A->in[6] + l * 4, A->in[7] + l * 4, (const float*)WSP(WS_GBA), (bf16*)WSP(WS_U), (bf16*)WSP(WS_Y), aib, scb); } }
        GSYNC();
        for (int g = obid(); g < N_GDN_UNITS; g += ogrid()) { KArgP A = kargs();
            const bf16* aib = (const bf16*)(l == 0 ? (unsigned char*)A->out : WSP(WS_WIN)); const float* scb = (const float*)((const unsigned char*)aib + 16 * MiB);
            gdn_seq(L, g, (const bf16*)WSP(WS_U), (bf16*)WSP(WS_Y), aib, scb); }

        for (;;) {
            volatile LAS int* MISC = (volatile LAS int*)(L + MISC_OFF);
            __syncthreads();
            if (otid() == 0) { KArgP A = kargs(); MISC[0] = (int)atomicAdd((unsigned*)WSP(WS_CTL) + 64 * (l + 1), 1u); }
            __syncthreads();
            const int w = __builtin_amdgcn_readfirstlane(MISC[0]);
            if (w >= N_LRU_UNITS + N_ATT_UNITS) break;
            KArgP A = kargs();
            if (w >= 384 && w < 384 + N_LRU_UNITS) {
                lru_unit(L, w - 384, A->in[13] + l * 512, (const bf16*)WSP(WS_U), (bf16*)WSP(WS_Y));
            } else {
                const int i = w < 384 ? w : w - N_LRU_UNITS, qb = 31 - (i >> 5), bhm = i & 31, b = bhm >> 3, hm = bhm & 7;
                typedef attn2::bf16 abf;
                const abf* U = (const abf*)WSP(WS_U); const size_t r0 = (size_t)b * SEQ;
                attn2::BlockRef<abf, abf> cur{U + (r0 + qb * 256) * NU + U_AQ + hm * 64, U + r0 * NU + U_AK + hm * 64, U + r0 * NU + U_AV + (hm >> 1) * 128,
                                              (abf*)WSP(WS_XN) + (r0 + qb * 256) * 1024 + hm * 128, qb * 256};
                attn2::Seam<abf> S;
                attn2::causal_swa_prime(cur, 1 << 30, (char*)lds, S);
                attn2::causal_swa_block(cur, cur, SEQ, 1 << 30, (char*)lds, S);
            }
        }
        GSYNC();
        { KArgP A = kargs(); combine_phase(l, A->in[3] + l * 256, A->in[4] + l * 128, A->in[8] + l * 128, (const bf16*)WSP(WS_XN), (const bf16*)WSP(WS_U), (bf16*)WSP(WS_Y)); }
        GSYNC();
        { KArgP A = kargs();
          pg8::Gemm g{(const bf16*)WSP(WS_Y), (const bf16*)WSP(WS_WOUT) + (size_t)l * DMODEL * NY, M, DMODEL, NY, NY}; pg8::StaticOrder S; S.init(M, DMODEL, ogrid(), obid());
          pg8::EpiRes E{l == 0 ? A->in[0] : (const float*)A->out, A->out, DMODEL};
          pg8::gemm_phase<pg8::EpiRes, pg8::StaticOrder, true, true>(L, g, S, E); }
        GSYNC();
        if (l == 0) { { KArgP A = kargs(); norm_phase(L, A->out, A->in[2] + (size_t)DMODEL * INC, A->in[1] + DMODEL, (bf16*)WSP(WS_XN), (float*)WSP(WS_GBA)); } GSYNC(); }
        else { KArgP A = kargs();
            final_norm_phase(A->out, A->in[15]);
        }

}

__global__ void __launch_bounds__(NTHR, 2) mega_fwd(Args args) {
    extern __shared__ __attribute__((aligned(16))) unsigned char lds[];
    LAS unsigned char* L = (LAS unsigned char*)lds;

    if (otid() < 2) ((volatile LAS unsigned*)(L + XB_LDS_OFF))[otid()] = 0u;
    { KArgP A = kargs(); if (obid() == 0) for (int i = otid(); i < 8192; i += NTHR) ((unsigned*)WSP(WS_CTL))[i] = 0u; }
    { KArgP A = kargs(); p0_weights(L, A->in[2], A->in[14], A->in[11], (bf16*)WSP(WS_WIN), (bf16*)WSP(WS_WOUT), (bf16*)WSP(WS_WG)); }
    __syncthreads();
    { KArgP A = kargs(); norm_phase(L, A->in[0], A->in[2], A->in[1], (bf16*)WSP(WS_XN), (float*)WSP(WS_GBA)); }
    cg::this_grid().sync();
    { KArgP A = kargs(); (void)xcd_barrier_post((unsigned*)(A->ws + WS_BAR), (volatile LAS unsigned*)(L + XB_LDS_OFF)); }

    layer_body<0>(L, lds);
    layer_body<1>(L, lds);
}

extern "C" void kernel_launch(void* const* d_in, const int* in_sizes, int n_in, void* d_out, int out_size, void* d_ws, size_t ws_size, hipStream_t stream) {
    static int grid = 0;
    if (grid == 0) {
        if (n_in != 16 || out_size != M * DMODEL || ws_size < WS_END) { fprintf(stderr, "kernel_launch: unexpected shapes (n_in %d out %d ws %zu)\n", n_in, out_size, ws_size); grid = -1; return; }
        int dev = 0, cus = 0, per_cu = 0;
        hipGetDevice(&dev); hipDeviceGetAttribute(&cus, hipDeviceAttributeMultiprocessorCount, dev);
        hipFuncSetAttribute((const void*)mega_fwd, hipFuncAttributeMaxDynamicSharedMemorySize, LDS_BYTES);
        hipOccupancyMaxActiveBlocksPerMultiprocessor(&per_cu, (const void*)mega_fwd, NTHR, LDS_BYTES);
        (void)hipGetLastError();
        if (per_cu < 1) { fprintf(stderr, "kernel_launch: occupancy query says %d blocks per CU\n", per_cu); per_cu = 1; }
        grid = cus;
    }
    if (grid < 0) return;
    Args a{};
    for (int i = 0; i < 16; ++i) a.in[i] = (const float*)d_in[i];
    a.out = (float*)d_out; a.ws = (unsigned char*)d_ws;
    void* kargs[] = {&a};
    hipError_t e = hipLaunchCooperativeKernel((const void*)mega_fwd, dim3(grid), dim3(NTHR), kargs, LDS_BYTES, stream);
    if (e != hipSuccess) fprintf(stderr, "cooperative launch failed: %s (grid %d)\n", hipGetErrorString(e), grid);
}
```
